# Optimizing an MI355X kernel written in HIP

```python
import math
import jax, jax.numpy as jnp
from jax import lax
import numpy as np

D_MODEL = 1024
BATCH = 4
SEQ = 4096
DEPTH = 1
DEC_BATCH = 32
DEC_SEQ = 1
PAST_LEN = 8192
PAGE_SIZE = 128

D_MIX = D_MODEL
D_A = D_MIX // 2
D_B = D_MIX - D_A
H_A = 4
DV_A = D_A // H_A
DK_A = DV_A // 2
GATE_RANK = 16
GATE_TEMP = 16.0
GLA_CHUNK = 64
H_B = 8
HD_B = D_B // H_B
DILATED_GROUPS = ((128, 1), (512, 4), (2048, 16))
WINDOW = 2048
ATTN_BLOCK = 128
N_BUCKETS = 32
MAX_EXACT = 16
MAX_DISTANCE = 2048
LN_EPS = 1e-5
RMS_EPS = 1e-6
DEEPNORM_ALPHA = (2.0 * DEPTH) ** 0.25
DEEPNORM_BETA = (8.0 * DEPTH) ** -0.25
SPLITS = (H_A * DK_A, H_A * DK_A, D_A, GATE_RANK, D_A, D_B, D_B, D_B, D_B)
D_IN = 256 + 256 + 512 + 16 + 512 + 512 + 512 + 512 + 512

kernel_name = "hymba_gla_dilated_swa_deepnorm_step"

F32 = jnp.float32


def layer_norm(x, g, b):
    xf = x.astype(F32)
    mu = jnp.mean(xf, axis=-1, keepdims=True)
    var = jnp.mean(jnp.square(xf - mu), axis=-1, keepdims=True)
    return ((xf - mu) * lax.rsqrt(var + LN_EPS) * g.astype(F32) + b.astype(F32)).astype(x.dtype)


def t5_bucket(dist):
    d = jnp.maximum(dist.astype(F32), 1.0)
    log_b = MAX_EXACT + jnp.log(d / MAX_EXACT) / math.log(MAX_DISTANCE / MAX_EXACT) * (N_BUCKETS - MAX_EXACT)
    log_b = jnp.minimum(log_b.astype(jnp.int32), N_BUCKETS - 1)
    return jnp.where(dist < MAX_EXACT, dist, log_b)


def gla_chunked(q, k, v, log_a, s0, chunk):
    B, T = q.shape[:2]
    n = T // chunk

    def to_chunks(a):
        return a.astype(F32).reshape(B, n, chunk, H_A, a.shape[-1]).transpose(1, 0, 3, 2, 4)

    causal = jnp.tril(jnp.ones((chunk, chunk), dtype=bool))

    def step(state, inp):
        qc, kc, vc, gc = inp
        b = jnp.cumsum(gc, axis=2)
        diff = b[:, :, :, None, :] - b[:, :, None, :, :]
        decay = jnp.exp(jnp.where(causal[None, None, :, :, None], diff, -jnp.inf))
        att = jnp.einsum('bhtd,bhsd,bhtsd->bhts', qc, kc, decay)
        o = (jnp.einsum('bhts,bhsv->bhtv', att, vc)
             + jnp.einsum('bhtd,bhdv->bhtv', qc * jnp.exp(b), state))
        b_last = b[:, :, -1:, :]
        new_state = (jnp.exp(b_last[:, :, 0, :])[..., None] * state
                     + jnp.einsum('bhsd,bhsv->bhdv', kc * jnp.exp(b_last - b), vc))
        return new_state, o

    s_final, o = lax.scan(step, s0.astype(F32), (to_chunks(q), to_chunks(k), to_chunks(v), to_chunks(log_a)))
    return o.transpose(1, 0, 3, 2, 4).reshape(B, T, H_A, DV_A), s_final


def dilated_attention(q, k_all, v_all, q_idx, rel_bias):
    L = k_all.shape[1]
    scale = HD_B ** -0.5
    qf = q.astype(F32)
    ms, ss, outs = [], [], []
    for window, dil in DILATED_GROUPS:
        dist = jnp.arange(window // dil + 1, dtype=jnp.int32) * dil
        idx = q_idx[:, None] - dist[None, :]
        valid = idx >= 0
        idx_c = jnp.clip(idx, 0, L - 1)
        kg = jnp.take(k_all, idx_c, axis=1).astype(F32)
        vg = jnp.take(v_all, idx_c, axis=1).astype(F32)
        bias = rel_bias[t5_bucket(dist)].astype(F32).T
        logits = jnp.einsum('bqhd,bqjhd->bhqj', qf, kg) * scale + bias[None, :, None, :]
        logits = jnp.where(valid[None, None], logits, -jnp.inf)
        m = jnp.max(logits, axis=-1, keepdims=True)
        p = jnp.exp(logits - m)
        s = jnp.sum(p, axis=-1, keepdims=True)
        outs.append(jnp.einsum('bhqj,bqjhd->bhqd', p, vg) / s)
        ms.append(m)
        ss.append(s)
    m_all = jnp.maximum(jnp.maximum(ms[0], ms[1]), ms[2])
    wts = [s * jnp.exp(m - m_all) for m, s in zip(ms, ss)]
    out = (wts[0] * outs[0] + wts[1] * outs[1] + wts[2] * outs[2]) / (wts[0] + wts[1] + wts[2])
    return out.transpose(0, 2, 1, 3)


def prompt_dilated(q, k, v, rel_bias):
    B, S = q.shape[:2]
    nb = S // ATTN_BLOCK
    qb = q.reshape(B, nb, ATTN_BLOCK, H_B, HD_B).transpose(1, 0, 2, 3, 4)

    def body(args):
        blk, q_blk = args
        q_idx = blk * ATTN_BLOCK + jnp.arange(ATTN_BLOCK, dtype=jnp.int32)
        return dilated_attention(q_blk, k, v, q_idx, rel_bias)

    out = lax.map(body, (jnp.arange(nb, dtype=jnp.int32), qb))
    return out.transpose(1, 0, 2, 3, 4).reshape(B, S, H_B, HD_B)


def mixer_layer(x, s0, k_past, v_past, w_in, w_alpha2, b_alpha, gla_norm_g, w_out, ln_g, ln_b, rel_bias):
    B, T, _ = x.shape
    h = jnp.einsum('btd,de->bte', x, w_in)
    split_points = [int(c) for c in np.cumsum(SPLITS)[:-1]]
    qa, ka, va, za, ga, qb, kb, vb, gb = jnp.split(h, split_points, axis=-1)

    log_a = jax.nn.log_sigmoid((jnp.einsum('btr,rk->btk', za, w_alpha2) + b_alpha).astype(F32)) / GATE_TEMP
    qa = qa.reshape(B, T, H_A, DK_A) * (DK_A ** -0.5)
    ka = ka.reshape(B, T, H_A, DK_A)
    va = va.reshape(B, T, H_A, DV_A)
    log_a = log_a.reshape(B, T, H_A, DK_A)
    chunk = GLA_CHUNK if T % GLA_CHUNK == 0 else T
    o_a, s_new = gla_chunked(qa, ka, va, log_a, s0, chunk)
    o_a = o_a * lax.rsqrt(jnp.mean(jnp.square(o_a), axis=-1, keepdims=True) + RMS_EPS) * gla_norm_g.astype(F32)
    o_a = o_a.reshape(B, T, D_A)

    qb = qb.reshape(B, T, H_B, HD_B)
    kb = kb.reshape(B, T, H_B, HD_B)
    vb = vb.reshape(B, T, H_B, HD_B)
    if k_past is None:
        o_b = prompt_dilated(qb, kb, vb, rel_bias)
        keep = min(WINDOW, T)
        k_rows, v_rows = kb[:, T - keep:], vb[:, T - keep:]
    else:
        w_past = k_past.shape[1]
        k_all = jnp.concatenate([k_past, kb], axis=1)
        v_all = jnp.concatenate([v_past, vb], axis=1)
        q_idx = w_past + jnp.arange(T, dtype=jnp.int32)
        o_b = dilated_attention(qb, k_all, v_all, q_idx, rel_bias)
        k_rows, v_rows = kb, vb
    o_b = o_b.reshape(B, T, D_B)

    mix = jnp.concatenate([o_a * jax.nn.silu(ga.astype(F32)), o_b * jax.nn.silu(gb.astype(F32))], axis=-1)
    y = jnp.einsum('bte,ed->btd', mix.astype(x.dtype), w_out)
    x_new = layer_norm(DEEPNORM_ALPHA * x + y, ln_g, ln_b)
    return x_new, s_new, k_rows, v_rows


def setup_inputs(seed: int = 0) -> dict:
    key = jax.random.key(seed)
    ks = jax.random.split(key, 14)
    w_past = min(WINDOW, PAST_LEN)
    x_prompt = jax.random.normal(ks[0], (BATCH, SEQ, D_MODEL), F32)
    x_sample = jax.random.normal(ks[1], (DEC_BATCH, DEC_SEQ, D_MODEL), F32)
    state_gla = 0.5 * jax.random.normal(ks[2], (DEPTH, DEC_BATCH, H_A, DK_A, DV_A), F32)
    cache_k_win = jax.random.normal(ks[3], (DEPTH, DEC_BATCH, w_past, H_B, HD_B), F32)
    cache_v_win = jax.random.normal(ks[4], (DEPTH, DEC_BATCH, w_past, H_B, HD_B), F32)
    col_scale = np.ones((D_IN,), np.float32)
    offs = np.cumsum((0,) + SPLITS)
    col_scale[offs[2]:offs[3]] = DEEPNORM_BETA
    col_scale[offs[7]:offs[8]] = DEEPNORM_BETA
    w_in = jax.random.normal(ks[5], (DEPTH, D_MODEL, D_IN), F32) * (D_MODEL ** -0.5) * jnp.asarray(col_scale)
    w_alpha2 = jax.random.normal(ks[6], (DEPTH, GATE_RANK, H_A * DK_A), F32) * (GATE_RANK ** -0.5)
    b_alpha = 0.1 * jax.random.normal(ks[7], (DEPTH, H_A * DK_A), F32)
    gla_norm_g = 1.0 + 0.02 * jax.random.normal(ks[8], (DEPTH, DV_A), F32)
    w_out = jax.random.normal(ks[9], (DEPTH, D_MIX, D_MODEL), F32) * (D_MIX ** -0.5) * DEEPNORM_BETA
    ln_g = 1.0 + 0.02 * jax.random.normal(ks[10], (DEPTH, D_MODEL), F32)
    ln_b = 0.02 * jax.random.normal(ks[11], (DEPTH, D_MODEL), F32)
    rel_bias = 0.5 * jax.random.normal(ks[12], (N_BUCKETS, H_B), F32)
    return {"x_prompt": x_prompt, "x_sample": x_sample, "state_gla": state_gla,
            "cache_k_win": cache_k_win, "cache_v_win": cache_v_win,
            "w_in": w_in, "w_alpha2": w_alpha2, "b_alpha": b_alpha, "gla_norm_g": gla_norm_g,
            "w_out": w_out, "ln_g": ln_g, "ln_b": ln_b, "rel_bias": rel_bias}


def reference(x_prompt, x_sample, state_gla, cache_k_win, cache_v_win, w_in, w_alpha2, b_alpha,
              gla_norm_g, w_out, ln_g, ln_b, rel_bias):
    yp, ys = x_prompt, x_sample
    sp_l, ss_l, kp_l, vp_l, ks_l, vs_l = [], [], [], [], [], []
    for l in range(DEPTH):
        params = (w_in[l], w_alpha2[l], b_alpha[l], gla_norm_g[l], w_out[l], ln_g[l], ln_b[l], rel_bias)
        s0p = jnp.zeros((yp.shape[0], H_A, DK_A, DV_A), F32)
        yp, sp, kp, vp = mixer_layer(yp, s0p, None, None, *params)
        ys, ss, kn, vn = mixer_layer(ys, state_gla[l], cache_k_win[l], cache_v_win[l], *params)
        sp_l.append(sp); ss_l.append(ss); kp_l.append(kp); vp_l.append(vp); ks_l.append(kn); vs_l.append(vn)
    state_gla_prompt = jnp.stack(sp_l)
    state_gla_sample = jnp.stack(ss_l)
    k_win_prompt = jnp.stack(kp_l)
    v_win_prompt = jnp.stack(vp_l)
    k_win_sample_new = jnp.stack(ks_l)
    v_win_sample_new = jnp.stack(vs_l)
    return (yp, ys, state_gla_prompt, state_gla_sample, k_win_prompt, v_win_prompt, k_win_sample_new, v_win_sample_new)
```

```cpp
#include <hip/hip_runtime.h>
#include <cstdio>
#include <cstdint>
namespace pg8 {
#define PG8_LAS __attribute__((address_space(3)))
typedef unsigned short bf16_t;
typedef short bf16x8 __attribute__((ext_vector_type(8)));
typedef float f32x4 __attribute__((ext_vector_type(4)));
typedef unsigned u32x4 __attribute__((ext_vector_type(4)));
constexpr int BM = 256, BK = 64, HALF = 128, HTB = HALF * BK * 2  , STAGE_BYTES = 8 * HTB, NXCD = 8, WGM = 8;

__host__ __device__ __forceinline__ int lds_byte(int r, int c) { const int st = (r >> 4) * 2 + (c >> 5), rr = r & 15, cc = c & 31, ob = rr * 64 + cc * 2; return st * 1024 + (ob ^ (((ob >> 9) & 1) << 5)); }
__host__ __device__ __forceinline__ void stage_rc(int b, int& R, int& C) { const int st = b / 1024, sb = b % 1024, swz = sb ^ (((sb >> 9) & 1) << 5); R = (st >> 1) * 16 + swz / 64; C = (st & 1) * 32 + (swz % 64) / 2; }
__host__ __device__ __forceinline__ int perm32(int rho) { const int n = rho >> 4, i = rho & 15; return 8 * (i >> 2) + 4 * n + (i & 3); }

struct Unit { int pm, pn; };
struct Gemm { const bf16_t* A; const bf16_t* Bt; int M, N, K; };

struct StaticOrder {
    int nM, nN, nwg, G, c;
    __host__ __device__ void init(int M, int N, int G_, int c_) { nM = M / BM; nN = N / BM; nwg = nM * nN; G = G_; c = c_; }
    __host__ __device__ bool next(int i, Unit& u) const {
        const long L = (long)i * G + c; if (L >= nwg) return false;
        int wgid = (int)L; { const int q = nwg / NXCD, r = nwg % NXCD, xcd = wgid % NXCD, off = wgid / NXCD; wgid = (xcd < r ? xcd * (q + 1) : r * (q + 1) + (xcd - r) * q) + off; }
        const int nig = WGM * nN, gid = wgid / nig, fm = gid * WGM, gsz = (nM - fm) < WGM ? (nM - fm) : WGM;
        u.pm = fm + ((wgid % nig) % gsz); u.pn = (wgid % nig) / gsz; return true;
    }
    __device__ __forceinline__ void a_ready(const Unit&) const {}
    __device__ __forceinline__ void done(const Unit&) const {}
};

__device__ __forceinline__ unsigned cvt_pk_bf16(float lo, float hi) { unsigned r; asm volatile("v_cvt_pk_bf16_f32 %0, %1, %2" : "=v"(r) : "v"(lo), "v"(hi)); return r; }
typedef float f32x2 __attribute__((ext_vector_type(2)));
__device__ __forceinline__ f32x2 gelu_pk(f32x2 v) {
    const f32x2 av = __builtin_elementwise_abs(v), d = av * 0.2316418882f + 1.0f;
    f32x2 t; t.x = __builtin_amdgcn_rcpf(d.x); t.y = __builtin_amdgcn_rcpf(d.y);
    f32x2 q = t * 0.5307027145f + (-0.7265760135f); q = q * t + 0.7107068705f; q = q * t + (-0.142248368f); q = q * t + 0.127414796f; q = q * t;
    const f32x2 s = (v * v) * (-0.72134752044f);
    f32x2 e; e.x = __builtin_amdgcn_exp2f(s.x); e.y = __builtin_amdgcn_exp2f(s.y);
    const f32x2 m = v * (q * e), r = v - m;
    f32x2 o; o.x = v.x < 0.f ? m.x : r.x; o.y = v.y < 0.f ? m.y : r.y; return o;
}

template <int ACT  > struct EpiBf16 {
    static constexpr bool PERM = true, AFTER_DRAIN = false; static_assert(ACT == 0 || ACT == 1, "EpiBf16: ACT is 0 (none) or 1 (gelu_pk)");
    bf16_t* O; int ldc; const float* bias; int split_cols; size_t split_stride; float scale0;
    __device__ __forceinline__ void operator()(const f32x4 (&acc)[2][2][4][2], const Unit& u, int wr, int wc, int fr, int fq) const {
        const int row0 = u.pm * BM + wr * 64 + fr; int colt = u.pn * BM; bf16_t* base = O;
        float sc = 1.f; if (split_cols) { const int t = colt / split_cols; base += (size_t)t * split_stride; colt -= t * split_cols; if (t == 0) sc = scale0; }
        const int col0 = colt + wc * 32 + 8 * fq, bcol0 = u.pn * BM + wc * 32 + 8 * fq;
        f32x4 bv[2][2];
#pragma unroll
        for (int bj = 0; bj < 2; ++bj)
#pragma unroll
            for (int n = 0; n < 2; ++n) bv[bj][n] = bias ? *(const f32x4*)(bias + bcol0 + bj * HALF + 4 * n) : (f32x4){0.f, 0.f, 0.f, 0.f};
#pragma unroll
        for (int ai = 0; ai < 2; ++ai)
#pragma unroll
            for (int m = 0; m < 4; ++m) { bf16_t* rowp = base + (size_t)(row0 + ai * HALF + m * 16) * ldc + col0;
#pragma unroll
                for (int bj = 0; bj < 2; ++bj) { f32x4 v0 = acc[ai][bj][m][0] + bv[bj][0], v1 = acc[ai][bj][m][1] + bv[bj][1];
                    if (ACT == 1) { f32x2 a = gelu_pk((f32x2){v0[0], v0[1]}), b = gelu_pk((f32x2){v0[2], v0[3]}), c = gelu_pk((f32x2){v1[0], v1[1]}), d = gelu_pk((f32x2){v1[2], v1[3]});
                        v0 = (f32x4){a.x, a.y, b.x, b.y}; v1 = (f32x4){c.x, c.y, d.x, d.y}; }
                    v0 = v0 * sc; v1 = v1 * sc; u32x4 w; w.x = cvt_pk_bf16(v0[0], v0[1]); w.y = cvt_pk_bf16(v0[2], v0[3]); w.z = cvt_pk_bf16(v1[0], v1[1]); w.w = cvt_pk_bf16(v1[2], v1[3]);
                    *(u32x4*)(rowp + bj * HALF) = w; } }
    }
};

struct PanelStats {
    unsigned* xbuf;
    unsigned* cnt;
    unsigned* tmo;
    int ntn; float eps;
    unsigned code;
    __device__ __forceinline__ bool run(const f32x4 (&v)[2][2][4][2], const Unit& u, int wr, int wc, int fr, int fq, PG8_LAS unsigned char* lds, int wid, int lane) const {
        typedef float f32x2v __attribute__((ext_vector_type(2)));
        PG8_LAS f32x2v* P = (PG8_LAS f32x2v*)lds;
        PG8_LAS f32x2v* S = (PG8_LAS f32x2v*)(lds + 8192);
        PG8_LAS unsigned* flag = (PG8_LAS unsigned*)(lds + 8192 + 2048);
#pragma unroll
        for (int ai = 0; ai < 2; ++ai)
#pragma unroll
            for (int m = 0; m < 4; ++m) {
                float s = 0.f;
#pragma unroll
                for (int bj = 0; bj < 2; ++bj)
#pragma unroll
                    for (int n = 0; n < 2; ++n) { const f32x4 x = v[ai][bj][m][n]; s += (x[0] + x[1]) + (x[2] + x[3]); }
                s += __shfl_xor(s, 16); s += __shfl_xor(s, 32);
                const float mw = s * (1.0f / 64.0f); float q = 0.f;
#pragma unroll
                for (int bj = 0; bj < 2; ++bj)
#pragma unroll
                    for (int n = 0; n < 2; ++n) { const f32x4 d = v[ai][bj][m][n] - mw; q += (d[0] * d[0] + d[1] * d[1]) + (d[2] * d[2] + d[3] * d[3]); }
                q += __shfl_xor(q, 16); q += __shfl_xor(q, 32);
                if (fq == 0) P[(ai * HALF + wr * 64 + m * 16 + fr) * 4 + wc] = (f32x2v){mw, q};
            }
        asm volatile("s_waitcnt lgkmcnt(0)" ::: "memory"); __builtin_amdgcn_s_barrier(); asm volatile("" ::: "memory");
#if defined(BROKEN_EXCHANGE_NO_WAIT)
#warning BROKEN CONTROL BUILD: the row-statistics exchange does not wait; results are wrong by design
        if (blockIdx.x >= 64) { const long long t0_ = clock64(); while (clock64() - t0_ < 60000) __builtin_amdgcn_s_sleep(8); }
#endif
        const int row = wid * 32 + (lane & 31);
        if (lane < 32) {
            const f32x2v a = P[row * 4 + 0], b = P[row * 4 + 1], c = P[row * 4 + 2], d = P[row * 4 + 3];
            const float mt = (a.x + b.x + c.x + d.x) * 0.25f;
            const float da = a.x - mt, db = b.x - mt, dc = c.x - mt, dd = d.x - mt;
            const float m2 = (a.y + b.y) + (c.y + d.y) + 64.0f * ((da * da + db * db) + (dc * dc + dd * dd));
            unsigned long long* slot = (unsigned long long*)xbuf + ((size_t)(u.pm * BM + row) * 4 + u.pn);
            __hip_atomic_store(slot, ((unsigned long long)__float_as_uint(m2) << 32) | __float_as_uint(mt), __ATOMIC_RELAXED, __HIP_MEMORY_SCOPE_AGENT);
        }
        asm volatile("s_waitcnt vmcnt(0)" ::: "memory");
        if (lane == 0) __hip_atomic_fetch_add(cnt + 64 * u.pm, 1u, __ATOMIC_RELAXED, __HIP_MEMORY_SCOPE_AGENT);
        if (wid == 0) {
            bool dead = false; const unsigned long long t0 = __builtin_amdgcn_s_memrealtime(); const unsigned want = 8u * (unsigned)ntn;
            for (;;) {
#if defined(BROKEN_EXCHANGE_NO_WAIT)
                break;
#endif
                if ((unsigned)__builtin_amdgcn_readfirstlane(__hip_atomic_load(cnt + 64 * u.pm, __ATOMIC_RELAXED, __HIP_MEMORY_SCOPE_AGENT)) >= want) break;
                if (__builtin_amdgcn_s_memrealtime() - t0 > 2000000ull) {
                    if (lane == 0) { unsigned expect = 0u; __hip_atomic_compare_exchange_strong(tmo + 1, &expect, code | (unsigned)(u.pm & 0xff), __ATOMIC_RELAXED, __ATOMIC_RELAXED, __HIP_MEMORY_SCOPE_AGENT);
                                     __hip_atomic_store(tmo, 1u, __ATOMIC_RELAXED, __HIP_MEMORY_SCOPE_AGENT); }
                    dead = true; break; }
                __builtin_amdgcn_s_sleep(2);
            }
            __builtin_amdgcn_fence(__ATOMIC_ACQUIRE, "agent");
            if (lane == 0) flag[0] = dead ? 1u : 0u;
        }
        asm volatile("s_waitcnt vmcnt(0) lgkmcnt(0)" ::: "memory"); __builtin_amdgcn_s_barrier(); asm volatile("" ::: "memory");
        const bool bad = flag[0] != 0u;
        if (lane < 32) {
            const unsigned long long* slot = (const unsigned long long*)xbuf + (size_t)(u.pm * BM + row) * 4; float mt[4], m2[4]; float ms = 0.f;
#pragma unroll
            for (int t = 0; t < 4; ++t) { if (t < ntn) { const unsigned long long w = __hip_atomic_load(slot + t, __ATOMIC_RELAXED, __HIP_MEMORY_SCOPE_AGENT); mt[t] = __uint_as_float((unsigned)w); m2[t] = __uint_as_float((unsigned)(w >> 32)); } else { mt[t] = 0.f; m2[t] = 0.f; } ms += mt[t]; }
            const float mean = ms / (float)ntn; float q = 0.f;
#pragma unroll
            for (int t = 0; t < 4; ++t) if (t < ntn) { const float dm = mt[t] - mean; q += m2[t] + 256.0f * dm * dm; }
            S[row] = (f32x2v){mean, 1.0f / sqrtf(q / (256.0f * (float)ntn) + eps)};
        }
        asm volatile("s_waitcnt lgkmcnt(0)" ::: "memory"); __builtin_amdgcn_s_barrier(); asm volatile("" ::: "memory");
        return bad;
    }
};
struct EpiLnRes {
    static constexpr bool PERM = false, AFTER_DRAIN = true;
    const float* base; float* out; int ldc; const float* bias; PanelStats st; unsigned poison;
    __device__ __forceinline__ void fused(f32x4 (&acc)[2][2][4][2], const Unit& u, int wr, int wc, int fr, int fq, PG8_LAS unsigned char* lds, int wid, int lane) const {
        typedef float f32x2v __attribute__((ext_vector_type(2)));
        const PG8_LAS f32x2v* S = (const PG8_LAS f32x2v*)(lds + 8192);
        const int col0 = u.pn * BM + wc * 32 + 4 * fq;
#pragma unroll
        for (int bj = 0; bj < 2; ++bj)
#pragma unroll
            for (int n = 0; n < 2; ++n) { const f32x4 bv = bias ? *(const f32x4*)(bias + col0 + bj * HALF + n * 16) : (f32x4){0.f, 0.f, 0.f, 0.f};
#pragma unroll
                for (int ai = 0; ai < 2; ++ai)
#pragma unroll
                    for (int m = 0; m < 4; ++m) acc[ai][bj][m][n] += bv; }
        f32x4 pre[4][2][2];
#pragma unroll
        for (int m = 0; m < 4; ++m) { const size_t off = (size_t)(u.pm * BM + wr * 64 + m * 16 + fr) * ldc + col0;
#pragma unroll
            for (int bj = 0; bj < 2; ++bj)
#pragma unroll
                for (int n = 0; n < 2; ++n) pre[m][bj][n] = *(const f32x4*)(base + off + bj * HALF + n * 16); }
        const bool bad = st.run(acc, u, wr, wc, fr, fq, lds, wid, lane) || poison != 0u;
        const float qnan = __builtin_nanf("");
#pragma unroll
        for (int ai = 0; ai < 2; ++ai)
#pragma unroll
            for (int m = 0; m < 4; ++m) { const int r = ai * HALF + wr * 64 + m * 16 + fr; const f32x2v sr = S[r]; const size_t off = (size_t)(u.pm * BM + r) * ldc + col0;
#pragma unroll
                for (int bj = 0; bj < 2; ++bj)
#pragma unroll
                    for (int n = 0; n < 2; ++n) { const f32x4 bs = ai == 0 ? pre[m][bj][n] : *(const f32x4*)(base + off + bj * HALF + n * 16); f32x4 o = bs + (acc[ai][bj][m][n] - sr.x) * sr.y;
                        if (bad) o = (f32x4){qnan, qnan, qnan, qnan}; *(f32x4*)(out + off + bj * HALF + n * 16) = o; }
                if (m & 1) asm volatile("" ::: "memory"); }
    }
};
struct EpiLnResLn {
    static constexpr bool PERM = false, AFTER_DRAIN = true;
    const float* base; float* out; bf16_t* xn; int ldc; const float* bias; PanelStats st1, st2; unsigned poison;
    __device__ __forceinline__ void fused(f32x4 (&acc)[2][2][4][2], const Unit& u, int wr, int wc, int fr, int fq, PG8_LAS unsigned char* lds, int wid, int lane) const {
        typedef float f32x2v __attribute__((ext_vector_type(2))); typedef unsigned u32x2v __attribute__((ext_vector_type(2)));
        const PG8_LAS f32x2v* S = (const PG8_LAS f32x2v*)(lds + 8192);
        const int col0 = u.pn * BM + wc * 32 + 4 * fq;
#pragma unroll
        for (int bj = 0; bj < 2; ++bj)
#pragma unroll
            for (int n = 0; n < 2; ++n) { const f32x4 bv = bias ? *(const f32x4*)(bias + col0 + bj * HALF + n * 16) : (f32x4){0.f, 0.f, 0.f, 0.f};
#pragma unroll
                for (int ai = 0; ai < 2; ++ai)
#pragma unroll
                    for (int m = 0; m < 4; ++m) acc[ai][bj][m][n] += bv; }
        bool bad = st1.run(acc, u, wr, wc, fr, fq, lds, wid, lane) || poison != 0u;
        const float qnan = __builtin_nanf("");
#pragma unroll
        for (int ai = 0; ai < 2; ++ai)
#pragma unroll
            for (int m = 0; m < 4; ++m) { const int r = ai * HALF + wr * 64 + m * 16 + fr; const f32x2v sr = S[r]; const size_t off = (size_t)(u.pm * BM + r) * ldc + col0;
#pragma unroll
                for (int bj = 0; bj < 2; ++bj)
#pragma unroll
                    for (int n = 0; n < 2; ++n) { const f32x4 bs = *(const f32x4*)(base + off + bj * HALF + n * 16); acc[ai][bj][m][n] = bs + (acc[ai][bj][m][n] - sr.x) * sr.y; }
                asm volatile("" : "+v"(acc[ai][0][m][0]), "+v"(acc[ai][0][m][1]), "+v"(acc[ai][1][m][0]), "+v"(acc[ai][1][m][1]));
                if (m & 1) asm volatile("" ::: "memory"); }
        const bool bad1 = bad;
        bad = st2.run(acc, u, wr, wc, fr, fq, lds, wid, lane) || bad;
#pragma unroll
        for (int ai = 0; ai < 2; ++ai)
#pragma unroll
            for (int m = 0; m < 4; ++m) { const int r = ai * HALF + wr * 64 + m * 16 + fr; const f32x2v sr = S[r]; const size_t off = (size_t)(u.pm * BM + r) * ldc + col0;
#pragma unroll
                for (int bj = 0; bj < 2; ++bj)
#pragma unroll
                    for (int n = 0; n < 2; ++n) { const f32x4 x1 = acc[ai][bj][m][n]; *(f32x4*)(out + off + bj * HALF + n * 16) = bad1 ? (f32x4){qnan, qnan, qnan, qnan} : x1;
                        const f32x4 o = (x1 - sr.x) * sr.y; u32x2v w; w.x = cvt_pk_bf16(o[0], o[1]); w.y = cvt_pk_bf16(o[2], o[3]);
                        if (bad) { w.x = 0x7fc07fc0u; w.y = 0x7fc07fc0u; } *(u32x2v*)(xn + off + bj * HALF + n * 16) = w; }
                asm volatile("" ::: "memory"); }
    }
};

template <class Epi, class Sched, bool ALIGN_EPI = false, bool SP2 = false>
__device__ __forceinline__ void gemm_phase(PG8_LAS unsigned char* lds, const Gemm g, const Sched& S, const Epi& E) {
    const int tid = threadIdx.x, wid = __builtin_amdgcn_readfirstlane(tid >> 6), lane = tid & 63, wr = wid >> 2, wc = wid & 3, fr = lane & 15, fq = lane >> 4;
    const int K = g.K, nt = K / BK;
    unsigned voffA[2], voffB[2];
#pragma unroll
    for (int i = 0; i < 2; ++i) { int R, C; stage_rc(tid * 16 + i * 8192, R, C); const int Rb = Epi::PERM ? ((R & ~31) + perm32(R & 31)) : R;
        voffA[i] = (unsigned)(R * K + C) * 2u; voffB[i] = (unsigned)(Rb * K + C) * 2u; }
    const size_t kstep = (size_t)(BK * 2);
    const size_t hstep = (size_t)HALF * K * 2;
    const size_t tstep = 2 * hstep;
    const unsigned ldsw = (unsigned)wid * 1024u;
    const int aoff = lds_byte(wr * 64 + fr, fq * 8), boff = lds_byte(wc * 32 + fr, fq * 8);
#define PG8_SA(b, h) (((b) * 2 + (h)) * HTB)
#define PG8_SB(b, h) ((4 + (b) * 2 + (h)) * HTB)
#define PG8_STAGE(bufoff, gbase, voff) do { _Pragma("unroll") for (int _i = 0; _i < 2; ++_i) \
        __builtin_amdgcn_global_load_lds((const unsigned*)((const char*)(gbase) + (voff)[_i]), (PG8_LAS unsigned*)(lds + (bufoff) + ldsw + _i * 8192), 16, 0, 0); } while (0)
#define PG8_LDA(dst, b, h) do { _Pragma("unroll") for (int m = 0; m < 4; ++m) _Pragma("unroll") for (int k = 0; k < 2; ++k) dst[m][k] = *(const PG8_LAS bf16x8*)(lds + PG8_SA(b, h) + aoff + m * 2048 + k * 1024); } while (0)
#define PG8_LDB(dst, b, h) do { _Pragma("unroll") for (int n = 0; n < 2; ++n) _Pragma("unroll") for (int k = 0; k < 2; ++k) dst[n][k] = *(const PG8_LAS bf16x8*)(lds + PG8_SB(b, h) + boff + n * 2048 + k * 1024); } while (0)
#define PG8_MMA(ai, bj, At, Bt) do { __builtin_amdgcn_s_setprio(1); _Pragma("unroll") for (int m = 0; m < 4; ++m) _Pragma("unroll") for (int n = 0; n < 2; ++n) _Pragma("unroll") for (int k = 0; k < 2; ++k) \
        acc[ai][bj][m][n] = __builtin_amdgcn_mfma_f32_16x16x32_bf16(Bt[n][k], At[m][k], acc[ai][bj][m][n], 0, 0, 0); __builtin_amdgcn_s_setprio(0); } while (0)
#define PG8_WAIT_V(n) asm volatile("s_waitcnt vmcnt(" #n ")" ::: "memory")
#define PG8_WAIT_L(n) asm volatile("s_waitcnt lgkmcnt(" #n ")" ::: "memory")
#define PG8_BAR __builtin_amdgcn_s_barrier()
#define PG8_SCHED __builtin_amdgcn_sched_barrier(0)
    Unit cur, nxt; int ui = 0;
    if (!S.next(0, cur)) return;
    f32x4 acc[2][2][4][2];
#pragma unroll
    for (int a = 0; a < 2; ++a)
#pragma unroll
        for (int b = 0; b < 2; ++b)
#pragma unroll
            for (int m = 0; m < 4; ++m)
#pragma unroll
                for (int n = 0; n < 2; ++n) acc[a][b][m][n] = (f32x4){0.f, 0.f, 0.f, 0.f};
    bf16x8 At[4][2], B0[2][2], B1[2][2];
    const char* cA = (const char*)g.A + (size_t)cur.pm * tstep; const char* cB = (const char*)g.Bt + (size_t)cur.pn * tstep;
    S.a_ready(cur);
    if constexpr (SP2) {
        PG8_STAGE(PG8_SB(0, 0), cB, voffB); PG8_STAGE(PG8_SB(0, 1), cB + hstep, voffB); PG8_STAGE(PG8_SA(0, 0), cA, voffA); PG8_STAGE(PG8_SA(0, 1), cA + hstep, voffA);
        if (wr == 1) PG8_BAR;
        PG8_WAIT_V(2); PG8_BAR;
        PG8_STAGE(PG8_SB(1, 0), cB + kstep, voffB); PG8_STAGE(PG8_SA(1, 0), cA + kstep, voffA); PG8_STAGE(PG8_SB(1, 1), cB + hstep + kstep, voffB);
        PG8_WAIT_V(6); PG8_BAR;
    } else {
        PG8_STAGE(PG8_SB(0, 0), cB, voffB); PG8_STAGE(PG8_SA(0, 0), cA, voffA); PG8_STAGE(PG8_SB(0, 1), cB + hstep, voffB); PG8_STAGE(PG8_SA(0, 1), cA + hstep, voffA);
        if (wr == 1) PG8_BAR;
        PG8_WAIT_V(4); PG8_BAR;
        PG8_STAGE(PG8_SB(1, 0), cB + kstep, voffB); PG8_STAGE(PG8_SA(1, 0), cA + kstep, voffA); PG8_STAGE(PG8_SB(1, 1), cB + hstep + kstep, voffB);
        PG8_WAIT_V(6); PG8_BAR;
    }
    for (;;) {
        const bool has_next = S.next(ui + 1, nxt);
        const char* nA = has_next ? (const char*)g.A + (size_t)nxt.pm * tstep : cA; const char* nB = has_next ? (const char*)g.Bt + (size_t)nxt.pn * tstep : cB;
        for (int t = 0; t < nt; t += 2) {
            const bool last = (t == nt - 2);
            const char* a1 = cA + (size_t)(t + 1) * kstep;
            const char* a2 = last ? nA : cA + (size_t)(t + 2) * kstep; const char* b2 = last ? nB : cB + (size_t)(t + 2) * kstep;
            const char* a3 = a2 + kstep; const char* b3 = b2 + kstep;
            if (last && has_next) S.a_ready(nxt);
            if constexpr (SP2) {
            PG8_LDB(B0, 0, 0); PG8_LDB(B1, 0, 1); PG8_SCHED; PG8_LDA(At, 0, 0); PG8_STAGE(PG8_SA(1, 1), a1 + hstep, voffA);
            PG8_WAIT_V(8); PG8_WAIT_L(0); PG8_BAR; PG8_MMA(0, 0, At, B0); PG8_MMA(0, 1, At, B1); PG8_BAR; PG8_SCHED;
            PG8_LDA(At, 0, 1); PG8_STAGE(PG8_SB(0, 0), b2, voffB); PG8_STAGE(PG8_SB(0, 1), b2 + hstep, voffB); PG8_STAGE(PG8_SA(0, 0), a2, voffA);
            PG8_WAIT_V(8); PG8_WAIT_L(0); PG8_BAR; PG8_MMA(1, 0, At, B0); PG8_MMA(1, 1, At, B1); PG8_BAR; PG8_SCHED;
            PG8_LDB(B0, 1, 0); PG8_LDB(B1, 1, 1); PG8_SCHED; PG8_LDA(At, 1, 0); PG8_STAGE(PG8_SA(0, 1), a2 + hstep, voffA);
            PG8_WAIT_V(8); PG8_WAIT_L(0); PG8_BAR; PG8_MMA(0, 0, At, B0); PG8_MMA(0, 1, At, B1); PG8_BAR; PG8_SCHED;
            PG8_LDA(At, 1, 1); PG8_STAGE(PG8_SB(1, 0), b3, voffB); PG8_STAGE(PG8_SB(1, 1), b3 + hstep, voffB); PG8_STAGE(PG8_SA(1, 0), a3, voffA);
            PG8_WAIT_V(8); PG8_WAIT_L(0); PG8_BAR; PG8_MMA(1, 0, At, B0); PG8_MMA(1, 1, At, B1); PG8_BAR; PG8_SCHED;
            } else {
            PG8_LDB(B0, 0, 0); PG8_SCHED; PG8_LDA(At, 0, 0); PG8_STAGE(PG8_SA(1, 1), a1 + hstep, voffA);
            PG8_WAIT_L(8); PG8_BAR; PG8_WAIT_L(0); PG8_MMA(0, 0, At, B0); PG8_BAR; PG8_SCHED;
            PG8_LDB(B1, 0, 1); PG8_STAGE(PG8_SB(0, 0), b2, voffB);
            PG8_BAR; PG8_WAIT_L(0); PG8_MMA(0, 1, At, B1); PG8_BAR;
            PG8_LDA(At, 0, 1); PG8_STAGE(PG8_SA(0, 0), a2, voffA);
            PG8_BAR; PG8_WAIT_L(0); PG8_MMA(1, 0, At, B0); PG8_BAR; PG8_SCHED;
            PG8_STAGE(PG8_SB(0, 1), b2 + hstep, voffB);
            PG8_WAIT_V(6); PG8_BAR; PG8_MMA(1, 1, At, B1); PG8_BAR;
            PG8_LDB(B0, 1, 0); PG8_SCHED; PG8_LDA(At, 1, 0); PG8_STAGE(PG8_SA(0, 1), a2 + hstep, voffA);
            PG8_WAIT_L(8); PG8_BAR; PG8_WAIT_L(0); PG8_MMA(0, 0, At, B0); PG8_BAR; PG8_SCHED;
            PG8_LDB(B1, 1, 1); PG8_STAGE(PG8_SB(1, 0), b3, voffB);
            PG8_BAR; PG8_WAIT_L(0); PG8_MMA(0, 1, At, B1); PG8_BAR;
            PG8_LDA(At, 1, 1); PG8_STAGE(PG8_SA(1, 0), a3, voffA);
            PG8_BAR; PG8_WAIT_L(0); PG8_MMA(1, 0, At, B0); PG8_BAR; PG8_SCHED;
            PG8_STAGE(PG8_SB(1, 1), b3 + hstep, voffB);
            PG8_WAIT_V(6); PG8_BAR; PG8_MMA(1, 1, At, B1); PG8_BAR;
            }
        }
        if constexpr (ALIGN_EPI) { if (wr == 0) PG8_BAR; }
        if constexpr (!Epi::AFTER_DRAIN) { E(acc, cur, wr, wc, fr, fq); S.done(cur); }
        if (!has_next) break;
#pragma unroll
        for (int a = 0; a < 2; ++a)
#pragma unroll
            for (int b = 0; b < 2; ++b)
#pragma unroll
                for (int m = 0; m < 4; ++m)
#pragma unroll
                    for (int n = 0; n < 2; ++n) acc[a][b][m][n] = (f32x4){0.f, 0.f, 0.f, 0.f};
        cur = nxt; cA = nA; cB = nB; ++ui;
        if constexpr (ALIGN_EPI) { if (wr == 1) PG8_BAR; }
    }
    PG8_WAIT_V(0);
    if constexpr (!ALIGN_EPI) { if (wr == 0) PG8_BAR; }
    PG8_BAR;
    if constexpr (Epi::AFTER_DRAIN) { E.fused(acc, cur, wr, wc, fr, fq, lds, wid, lane); S.done(cur); }
#undef PG8_SA
#undef PG8_SB
#undef PG8_STAGE
#undef PG8_LDA
#undef PG8_LDB
#undef PG8_MMA
#undef PG8_WAIT_V
#undef PG8_WAIT_L
#undef PG8_BAR
#undef PG8_SCHED
}
}
#define GAS __attribute__((address_space(1)))
#define LAS __attribute__((address_space(3)))
typedef unsigned short bf16;
typedef unsigned v4u __attribute__((ext_vector_type(4)));
typedef float f32x4 __attribute__((ext_vector_type(4)));
typedef short bf16x8 __attribute__((ext_vector_type(8)));
typedef GAS unsigned gu32;
typedef GAS unsigned long long gu64;
#define RLX_AGENT __ATOMIC_RELAXED, __HIP_MEMORY_SCOPE_AGENT
#define LDS_WAIT() asm volatile("s_waitcnt lgkmcnt(0)" ::: "memory")
#define VM_WAIT() asm volatile("s_waitcnt vmcnt(0)" ::: "memory")
__device__ __forceinline__ unsigned long long rt() { return __builtin_amdgcn_s_memrealtime(); }
__device__ __forceinline__ unsigned f2bf(float f) { unsigned u = __builtin_bit_cast(unsigned, f); return (u + 0x7fffu + ((u >> 16) & 1u)) >> 16; }
__device__ __forceinline__ unsigned pk2(float lo, float hi) { return f2bf(lo) | (f2bf(hi) << 16); }

#define XB_TMO      128
#define XB_XCNT(j)  (256  + 64 * (j))
#define XB_XSUB(j)  (1280 + 64 * (j))
#define XB_XGEN(j)  (2304 + 64 * (j))
#define XB_TOP      3328
#define XB_TOPGEN   3392
#define XCD_BAR_WORDS 3456
#define XB_SPIN_CAP (1u << 18)

__device__ __forceinline__ unsigned xb_ld(unsigned* p)              { return __hip_atomic_load(p, __ATOMIC_RELAXED, __HIP_MEMORY_SCOPE_AGENT); }
__device__ __forceinline__ unsigned xb_add(unsigned* p, unsigned v) { return __hip_atomic_fetch_add(p, v, __ATOMIC_RELAXED, __HIP_MEMORY_SCOPE_AGENT); }
__device__ __forceinline__ unsigned xb_xcc_id() { return (unsigned)__builtin_amdgcn_s_getreg((3 << 11) | 20) & 0xFu; }
#define XB_SPIN(cond, bar) do { unsigned _sp = 0; while (cond) { __builtin_amdgcn_s_sleep(1); \
    if ((++_sp & 255u) == 0u) { if (xb_ld(&(bar)[XB_TMO])) break; if (_sp > XB_SPIN_CAP) { atomicAdd(&(bar)[XB_TMO], 1u); break; } } } } while (0)

struct XcdBarrier {
    unsigned* bar; unsigned x;
    volatile LAS unsigned* st;
};

__device__ __forceinline__ XcdBarrier xcd_barrier_post(unsigned* bar, volatile LAS unsigned* st) {
    XcdBarrier b; b.bar = bar; b.x = xb_xcc_id(); b.st = st;
    if (threadIdx.x == 0) (void)xb_add(&bar[XB_XCNT(b.x)], 1u);
    return b;
}
__device__ __forceinline__ void xcd_barrier_complete(unsigned* bar, unsigned x, unsigned& nloc, unsigned& nx) {
    const unsigned G = gridDim.x * gridDim.y * gridDim.z;
    unsigned sum, cnt, mine, sp = 0u;
    for (;;) {
        sum = 0u; cnt = 0u; mine = 0u;
#pragma unroll
        for (unsigned j = 0; j < 16; ++j) { const unsigned c = xb_ld(&bar[XB_XCNT(j)]); sum += c; cnt += (c > 0u) ? 1u : 0u; mine = (j == x) ? c : mine; }
        if (sum == G) break;
        __builtin_amdgcn_s_sleep(1);
        if ((++sp & 255u) == 0u) { if (xb_ld(&bar[XB_TMO])) break; if (sp > XB_SPIN_CAP) { atomicAdd(&bar[XB_TMO], 1u); break; } }
    }
    nloc = mine > 0u ? mine : 1u; nx = cnt > 0u ? cnt : 1u;
}

__device__ __forceinline__ void xcd_barrier(const XcdBarrier& b) {
    asm volatile("s_waitcnt vmcnt(0)" ::: "memory");
    __syncthreads();
    if (threadIdx.x == 0) {
        unsigned* bar = b.bar;
        __builtin_amdgcn_s_waitcnt(0);
        unsigned nloc = b.st[0], nx = b.st[1];
        if (nloc == 0u) { xcd_barrier_complete(bar, b.x, nloc, nx); b.st[0] = nloc; b.st[1] = nx; }
        const unsigned old = xb_add(&bar[XB_XSUB(b.x)], 1u);
        const unsigned gen = old / nloc;
        if (old + 1u == (gen + 1u) * nloc) {
            __builtin_amdgcn_fence(__ATOMIC_RELEASE, "agent");
            asm volatile("s_waitcnt vmcnt(0)" ::: "memory");
            const unsigned og = xb_add(&bar[XB_TOP], 1u);
            const unsigned tg = og / nx;
            if (og + 1u == (tg + 1u) * nx) xb_add(&bar[XB_TOPGEN], 1u);
            else XB_SPIN(xb_ld(&bar[XB_TOPGEN]) == tg, bar);
            __builtin_amdgcn_fence(__ATOMIC_ACQUIRE, "agent");
            xb_add(&bar[XB_XGEN(b.x)], 1u);
            asm volatile("s_waitcnt vmcnt(0)" ::: "memory");
        } else {
            XB_SPIN(xb_ld(&bar[XB_XGEN(b.x)]) == gen, bar);
            __builtin_amdgcn_fence(__ATOMIC_ACQUIRE, "agent");
            asm volatile("s_waitcnt vmcnt(0)" ::: "memory");
        }
    }
    __syncthreads();
}

constexpr int NWAVES = 8, NTHR = 512;
constexpr int DM = 1024, SEQ = 4096, NBATCH = 4, MTOK = NBATCH * SEQ, NSAMP = 32, MP = 16640;
constexpr int NH = 3840;
constexpr int DIN = 3600;
constexpr int C_QA = 0, C_KA = 256, C_VA = 512, C_GT = 1024, C_GA = 1280, C_QB = 1792, C_KB = 2304, C_VB = 2816, C_GB = 3328;
constexpr int WPAST = 2048;
constexpr float LOG2E = 1.4426950408889634f;
constexpr float ALPHA = 1.189207115002721f;
constexpr float LN_EPS = 1e-5f, RMS_EPS = 1e-6f;

constexpr size_t MiB = 1u << 20;
constexpr size_t WS_CTL = 0, CTL_ZERO_BYTES = 1 * MiB;
constexpr size_t WS_WIN = 2 * MiB;
constexpr size_t WS_WO = 10 * MiB;
constexpr size_t WS_XB = 12 * MiB;
constexpr size_t WS_H = 48 * MiB;
constexpr size_t WS_MIX = 172 * MiB;
constexpr size_t WS_U = 208 * MiB;
constexpr size_t WS_SBT = 240 * MiB;
constexpr size_t WS_DEC = 256 * MiB;
constexpr size_t WS_OP = 258 * MiB;
constexpr size_t WS_MS = 274 * MiB;
constexpr size_t WS_YPRE = 276 * MiB;
constexpr size_t WS_END = 342 * MiB;
constexpr int CW_BAR = 4096;

constexpr size_t O_YP = 0, O_YS = 16777216, O_SP = O_YS + 32768, O_SS = O_SP + 131072, O_KP = O_SS + 1048576, O_VP = O_KP + 4194304, O_KS = O_VP + 4194304, O_VS = O_KS + 16384, O_END = O_VS + 16384;

constexpr int RING_OFF = 0, RING_BYTES = 131072;
constexpr int LDSCTL_OFF = RING_BYTES, MISC_OFF = LDSCTL_OFF + 320;
constexpr int LDS_BYTES = 147456;

typedef float f32x16 __attribute__((ext_vector_type(16)));
typedef float f32x2_t __attribute__((ext_vector_type(2)));
typedef __bf16 bf16x2_t __attribute__((ext_vector_type(2)));
__device__ __forceinline__ unsigned cvtpk(float lo, float hi) { f32x2_t v = {lo, hi}; bf16x2_t b = __builtin_convertvector(v, bf16x2_t); return __builtin_bit_cast(unsigned, b); }
__device__ __forceinline__ unsigned short f2bfs(float f) { return (unsigned short)(cvtpk(f, 0.f) & 0xffffu); }
__device__ __forceinline__ float bf2f(unsigned short h) { return __uint_as_float(((unsigned)h) << 16); }
__device__ __forceinline__ float bflo(unsigned w) { return __uint_as_float(w << 16); }
__device__ __forceinline__ float bfhi(unsigned w) { return __uint_as_float(w & 0xffff0000u); }
__device__ __forceinline__ int crow(int r, int hi) { return (r & 3) + 8 * (r >> 2) + 4 * hi; }
__device__ __forceinline__ float wave_sum(float v) {
#pragma unroll
    for (int o = 1; o < 64; o <<= 1) v += __shfl_xor(v, o);
    return v;
}
__device__ __forceinline__ int t5_bucket(int dist) {
    if (dist < 16) return dist;
    const float d = (float)dist;
    const float lb = 16.f + logf(d / 16.f) / 4.852030263919617f * 16.f;
    const int b = (int)lb;
    return b < 31 ? b : 31;
}
__device__ __forceinline__ float logsig(float p) { return fminf(p, 0.f) - log1pf(expf(-fabsf(p))); }
__device__ __forceinline__ float siluf(float v) { return v / (1.f + expf(-v)); }

namespace pg8 {
struct EpiInProj {
    static constexpr bool PERM = true, AFTER_DRAIN = false;
    bf16_t* H; const float* b_alpha; float* kwp; float* vwp; float* kws; float* vws;
    __device__ __forceinline__ void operator()(const f32x4 (&acc)[2][2][4][2], const Unit& u, int wr, int wc, int fr, int fq) const {
        const int pn = u.pn;
        const int kind = (pn == 4) ? 1 : ((pn == 5 || pn == 6 || pn >= 13) ? 2 : ((pn >= 9 && pn <= 12) ? 3 : 0));
        const int row0 = u.pm * BM + wr * 64 + fr;
        const int col0 = pn * BM + wc * 32 + 8 * fq;
        f32x4 bv[2][2];
#pragma unroll
        for (int bj = 0; bj < 2; ++bj)
#pragma unroll
            for (int n = 0; n < 2; ++n) bv[bj][n] = (kind == 1) ? *(const f32x4*)(b_alpha + (col0 - 1024) + bj * HALF + 4 * n) : (f32x4){0.f, 0.f, 0.f, 0.f};
#pragma unroll
        for (int ai = 0; ai < 2; ++ai)
#pragma unroll
            for (int m = 0; m < 4; ++m) {
                const int row = row0 + ai * HALF + m * 16;
                bf16_t* rowp = H + (size_t)row * 3840 + col0;
                float* fdst = nullptr;
                if (kind == 3) {
                    const bool isv = (pn >= 11);
                    const int c = (pn - (isv ? 11 : 9)) * BM + wc * 32 + 8 * fq;
                    if (row < 16384) { const int t = row & 4095, b = row >> 12; if (t >= 2048) fdst = (isv ? vwp : kwp) + ((size_t)(b * 2048 + (t - 2048)) * 512 + c); }
                    else if (row < 16416) fdst = (isv ? vws : kws) + (size_t)(row - 16384) * 512 + c;
                }
#pragma unroll
                for (int bj = 0; bj < 2; ++bj) {
                    f32x4 v0 = acc[ai][bj][m][0], v1 = acc[ai][bj][m][1];
                    if (kind == 1) {
                        v0 = v0 + bv[bj][0]; v1 = v1 + bv[bj][1];
#pragma unroll
                        for (int e = 0; e < 4; ++e) { v0[e] = logsig(v0[e]) * 0.0625f; v1[e] = logsig(v1[e]) * 0.0625f; }
                    } else if (kind == 2) {
#pragma unroll
                        for (int e = 0; e < 4; ++e) { v0[e] = siluf(v0[e]); v1[e] = siluf(v1[e]); }
                    }
                    u32x4 w; w.x = cvt_pk_bf16(v0[0], v0[1]); w.y = cvt_pk_bf16(v0[2], v0[3]); w.z = cvt_pk_bf16(v1[0], v1[1]); w.w = cvt_pk_bf16(v1[2], v1[3]);
                    *(u32x4*)(rowp + bj * HALF) = w;
                    if (kind == 3 && fdst) { *(f32x4*)(fdst + bj * HALF) = v0; *(f32x4*)(fdst + bj * HALF + 4) = v1; }
                }
            }
    }
};
struct EpiYpre {
    static constexpr bool PERM = false, AFTER_DRAIN = false;
    float* Y; const float* x;
    __device__ __forceinline__ void operator()(const f32x4 (&acc)[2][2][4][2], const Unit& u, int wr, int wc, int fr, int fq) const {
        const int row0 = u.pm * BM + wr * 64 + fr, col0 = u.pn * BM + wc * 32 + 4 * fq;
#pragma unroll
        for (int ai = 0; ai < 2; ++ai)
#pragma unroll
            for (int m = 0; m < 4; ++m) {
                const size_t off = (size_t)(row0 + ai * HALF + m * 16) * 1024 + col0;
#pragma unroll
                for (int bj = 0; bj < 2; ++bj)
#pragma unroll
                    for (int n = 0; n < 2; ++n) { const f32x4 xv = *(const f32x4*)(x + off + bj * HALF + n * 16); *(f32x4*)(Y + off + bj * HALF + n * 16) = acc[ai][bj][m][n] + xv * 1.189207115002721f; }
            }
    }
};
}

struct Frame {
    LAS unsigned char* lds;
    volatile LAS unsigned* MISC;
    gu32* ctl;
    int tid, lane, wave, G, blk;
    const float *x_prompt, *x_sample, *state_gla, *cache_k, *cache_v, *w_in, *w_alpha2, *b_alpha, *gnorm, *w_out, *ln_g, *ln_b, *rel_bias;
    float* out;
    bf16 *WinT, *WoT, *XB, *H, *MIX, *SBT, *OP;
    float *U, *DEC, *MS, *YPRE;
};

__device__ __forceinline__ void p0_transpose(const float* W, int ldw, int srccol0, bf16* WT, int dstrow0, float scale, LAS float* scr, int kb, int lane) {
    const int k0 = 64 * kb;
#pragma unroll 8
    for (int i = 0; i < 32; ++i) { const int kk = 2 * i + (lane >> 5); scr[kk * 33 + (lane & 31)] = W[(size_t)(k0 + kk) * ldw + srccol0 + (lane & 31)]; }
    LDS_WAIT(); asm volatile("" ::: "memory");
    const int c = lane & 7;
#pragma unroll
    for (int j = 0; j < 4; ++j) { const int n = (lane >> 3) + 8 * j; const LAS float* s = scr + (8 * c) * 33 + n;
        v4u o; o.x = cvtpk(s[0 * 33] * scale, s[1 * 33] * scale); o.y = cvtpk(s[2 * 33] * scale, s[3 * 33] * scale); o.z = cvtpk(s[4 * 33] * scale, s[5 * 33] * scale); o.w = cvtpk(s[6 * 33] * scale, s[7 * 33] * scale);
        *(GAS v4u*)(WT + (size_t)(dstrow0 + n) * 1024 + k0 + 8 * c) = o; }
    LDS_WAIT(); asm volatile("" ::: "memory");
}
__device__ __forceinline__ void p0_prologue(Frame& F) {
    LAS float* scr = (LAS float*)(F.lds + RING_OFF + F.wave * 16384);
    const int gw = F.blk * NWAVES + F.wave, NGW = F.G * NWAVES;
    constexpr int I_WIN = 112 * 16, I_WO = 32 * 16, I_GT = 128, NITEMS = I_WIN + I_WO + I_GT;
    for (int it = gw; it < NITEMS; it += NGW) {
        int r = it;
        if (r < I_WIN) { const int ntile = r >> 4, kb = r & 15; const int nt = ntile < 32 ? ntile : ntile + 8; const int drow = 32 * nt; const int scol = drow < 1024 ? drow : drow - 240;
            const float sc = (drow < 256 || (drow >= C_QB && drow < C_KB)) ? 0.125f : 1.0f;
            p0_transpose(F.w_in, DIN, scol, F.WinT, drow, sc, scr, kb, F.lane); continue; }
        r -= I_WIN;
        if (r < I_WO) { const int nt = r >> 4, kb = r & 15; p0_transpose(F.w_out, 1024, 32 * nt, F.WoT, 32 * nt, 1.0f, scr, kb, F.lane); continue; }
        r -= I_WO;
        {
            const int kt = r & 15, jt = r >> 4; const int k = 64 * kt + F.lane;
            const float* zr = F.w_in + (size_t)k * DIN + 1024;
            f32x4 z[4];
#pragma unroll
            for (int i = 0; i < 4; ++i) z[i] = *(const GAS f32x4*)(zr + 4 * i);
            for (int jj = 0; jj < 32; ++jj) { const int j = 32 * jt + jj; float dot = 0.f;
#pragma unroll
                for (int rr = 0; rr < 16; ++rr) dot += z[rr >> 2][rr & 3] * F.w_alpha2[rr * 256 + j];
                F.WinT[(size_t)(1024 + j) * 1024 + k] = f2bfs(dot); }
        }
    }
    for (int m = gw; m < MP; m += NGW) {
        GAS unsigned long long* o8 = (GAS unsigned long long*)(F.XB + (size_t)m * 1024) + F.lane;
        if (m < MTOK + NSAMP) {
            const float* src = (m < MTOK) ? F.x_prompt + (size_t)m * 1024 : F.x_sample + (size_t)(m - MTOK) * 1024;
            const GAS f32x4* xr = (const GAS f32x4*)src + F.lane;
#pragma unroll
            for (int j = 0; j < 4; ++j) { const f32x4 v = xr[64 * j]; o8[64 * j] = (unsigned long long)cvtpk(v.x, v.y) | ((unsigned long long)cvtpk(v.z, v.w) << 32); }
        } else {
#pragma unroll
            for (int j = 0; j < 4; ++j) o8[64 * j] = 0ull;
        }
    }
}

template <int PAT>
__device__ __forceinline__ void attn_unit(Frame& F, int u) {
    constexpr int d = (PAT == 0) ? 1 : ((PAT == 1) ? 4 : 16);
    const int tid = F.tid, lane = F.lane, w = F.wave;
    const int bh = u >> 4, rem = u & 15, r = rem % d, j = rem / d, b = bh >> 3, h = bh & 7;
    LAS unsigned char* Kl = F.lds; LAS unsigned char* VTl = F.lds + 55296;
    LAS float* tab = (LAS float*)(F.lds + 105984); LAS float* wsf = (LAS float*)(F.lds + 106752) + w * 128;
    const bf16* Hb = F.H + (size_t)b * SEQ * NH;
#pragma unroll
    for (int it = 0; it < 6; ++it) {
        const int idx = tid + 512 * it, kvrow = idx >> 3, c = idx & 7;
        const int ii = 256 * j - 128 + kvrow;
        if (ii >= 0) {
            const bf16* rowp = Hb + (size_t)(r + d * ii) * NH + h * 64 + c * 8;
            const v4u kk = *(const GAS v4u*)(rowp + C_KB), vv = *(const GAS v4u*)(rowp + C_VB);
            *(LAS v4u*)(Kl + kvrow * 144 + c * 16) = kk;
            LAS unsigned short* vt = (LAS unsigned short*)(VTl + (8 * c) * 792 + kvrow * 2);
            vt[0 * 396] = (unsigned short)(vv.x & 0xffffu); vt[1 * 396] = (unsigned short)(vv.x >> 16);
            vt[2 * 396] = (unsigned short)(vv.y & 0xffffu); vt[3 * 396] = (unsigned short)(vv.y >> 16);
            vt[4 * 396] = (unsigned short)(vv.z & 0xffffu); vt[5 * 396] = (unsigned short)(vv.z >> 16);
            vt[6 * 396] = (unsigned short)(vv.w & 0xffffu); vt[7 * 396] = (unsigned short)(vv.w >> 16);
        }
    }
    if (tid < 192) { const int ds = tid - 32; float v = -1e30f; if (ds >= 0 && ds <= 128) v = F.rel_bias[t5_bucket(d * ds) * 8 + h] * LOG2E; tab[tid] = v; }
    const int q = lane & 31, hi = lane >> 5;
    const int iq = 256 * j + 32 * w + q;
    const size_t growq = (size_t)b * SEQ + r + d * iq;
    bf16x8 qf[4];
    { const bf16* qp = F.H + growq * NH + C_QB + h * 64 + hi * 8;
#pragma unroll
      for (int ks = 0; ks < 4; ++ks) qf[ks] = *(const GAS bf16x8*)(qp + ks * 16); }
    __syncthreads();
    const int kt_lo = (j == 0) ? (w > 4 ? w : 4) : w;
    f32x16 X[5];
    float mx = -3e38f;
#pragma unroll
    for (int tt = 0; tt < 5; ++tt) {
        const int kt = w + tt;
        if (kt >= kt_lo) {
            f32x16 acc;
#pragma unroll
            for (int e = 0; e < 16; ++e) acc[e] = 0.f;
            const LAS unsigned char* kp = Kl + (kt * 32 + q) * 144 + hi * 16;
#pragma unroll
            for (int ks = 0; ks < 4; ++ks) acc = __builtin_amdgcn_mfma_f32_32x32x16_bf16(*(const LAS bf16x8*)(kp + ks * 32), qf[ks], acc, 0, 0, 0);
            const LAS float* tp = tab + (160 - 32 * tt + q - 4 * hi);
#pragma unroll
            for (int e = 0; e < 16; ++e) { const int kvo = (e & 3) + 8 * (e >> 2); const float v = acc[e] * LOG2E + tp[-kvo]; acc[e] = v; mx = fmaxf(mx, v); }
            X[tt] = acc;
        } else {
#pragma unroll
            for (int e = 0; e < 16; ++e) X[tt][e] = 0.f;
        }
    }
    mx = fmaxf(mx, __shfl_xor(mx, 32));
    float sum = 0.f;
#pragma unroll
    for (int tt = 0; tt < 5; ++tt) {
        if (w + tt >= kt_lo) {
#pragma unroll
            for (int e = 0; e < 16; ++e) { const float p = __builtin_amdgcn_exp2f(X[tt][e] - mx); X[tt][e] = p; sum += p; }
        }
    }
    sum += __shfl_xor(sum, 32);
    f32x16 o0, o1;
#pragma unroll
    for (int e = 0; e < 16; ++e) { o0[e] = 0.f; o1[e] = 0.f; }
    const int dcol = lane & 31;
#pragma unroll
    for (int tt = 0; tt < 5; ++tt) {
        if (w + tt >= kt_lo) {
#pragma unroll
            for (int s2 = 0; s2 < 2; ++s2) {
                v4u pw; pw.x = cvtpk(X[tt][8 * s2 + 0], X[tt][8 * s2 + 1]); pw.y = cvtpk(X[tt][8 * s2 + 2], X[tt][8 * s2 + 3]); pw.z = cvtpk(X[tt][8 * s2 + 4], X[tt][8 * s2 + 5]); pw.w = cvtpk(X[tt][8 * s2 + 6], X[tt][8 * s2 + 7]);
                const bf16x8 pa = __builtin_bit_cast(bf16x8, pw);
                const int kvb = (w + tt) * 32 + 16 * s2 + 4 * hi;
                const LAS unsigned char* vp = VTl + dcol * 792 + kvb * 2;
                typedef unsigned long long u64x2 __attribute__((ext_vector_type(2)));
                u64x2 b0, b1;
                b0.x = *(const LAS unsigned long long*)(vp); b0.y = *(const LAS unsigned long long*)(vp + 16);
                b1.x = *(const LAS unsigned long long*)(vp + 32 * 792); b1.y = *(const LAS unsigned long long*)(vp + 32 * 792 + 16);
                o0 = __builtin_amdgcn_mfma_f32_32x32x16_bf16(pa, __builtin_bit_cast(bf16x8, b0), o0, 0, 0, 0);
                o1 = __builtin_amdgcn_mfma_f32_32x32x16_bf16(pa, __builtin_bit_cast(bf16x8, b1), o1, 0, 0, 0);
            }
        }
    }
    float fc, fp = 0.f;
    float* msp = F.MS + (growq * 8 + h) * 2;
    if (PAT == 0) { fc = 1.f / sum; if (hi == 0) { msp[0] = mx; msp[1] = sum; } }
    else {
        const float mp = msp[0], sp = msp[1];
        const float mn = fmaxf(mp, mx); const float a = sp * __builtin_amdgcn_exp2f(mp - mn), c = __builtin_amdgcn_exp2f(mx - mn);
        const float sn = a + c * sum, inv = 1.f / sn;
        fp = a * inv; fc = c * inv;
        if (PAT == 1 && hi == 0) { msp[0] = mn; msp[1] = sn; }
    }
    if (hi == 0) { wsf[q] = fc; wsf[32 + q] = fp; }
    asm volatile("s_waitcnt lgkmcnt(0)" ::: "memory");
#pragma unroll
    for (int e = 0; e < 16; ++e) {
        const int qrow = crow(e, hi);
        const float fcr = wsf[qrow], fpr = wsf[32 + qrow];
        const size_t grow = (size_t)b * SEQ + r + d * (256 * j + 32 * w + qrow);
        bf16* op = F.OP + grow * 512 + h * 64 + dcol;
        float v0 = o0[e] * fcr, v1 = o1[e] * fcr;
        if (PAT >= 1) { v0 += bf2f(op[0]) * fpr; v1 += bf2f(op[32]) * fpr; }
        if (PAT < 2) { op[0] = f2bfs(v0); op[32] = f2bfs(v1); }
        else { const bf16* gp = F.H + grow * NH + C_GB + h * 64 + dcol; bf16* mp2 = F.MIX + grow * 1024 + 512 + h * 64 + dcol; mp2[0] = f2bfs(v0 * bf2f(gp[0])); mp2[32] = f2bfs(v1 * bf2f(gp[32])); }
    }
    __syncthreads();
}

__device__ __forceinline__ void gla_cumsum(Frame& F, const bf16* Hrow0, int h, LAS float* TOT, float (&bc)[8], float& blast) {
    const int grp = F.wave, dcol = F.lane;
    float run = 0.f;
#pragma unroll
    for (int e = 0; e < 8; ++e) { run += bf2f(Hrow0[(size_t)(8 * grp + e) * NH + C_GT + h * 64 + dcol]); bc[e] = run; }
    TOT[grp * 64 + dcol] = run;
    __syncthreads();
    float pre = 0.f, tot = 0.f;
#pragma unroll
    for (int g = 0; g < 8; ++g) { const float t = TOT[g * 64 + dcol]; tot += t; if (g < grp) pre += t; }
#pragma unroll
    for (int e = 0; e < 8; ++e) bc[e] += pre;
    blast = tot;
}
__device__ __forceinline__ void gla_stage_vt(Frame& F, const bf16* Hrow0, int h, LAS unsigned char* VT) {
    const int grp = F.wave, dcol = F.lane;
#pragma unroll
    for (int half = 0; half < 2; ++half) {
        const int dv = dcol + 64 * half; float v[8];
#pragma unroll
        for (int e = 0; e < 8; ++e) v[e] = bf2f(Hrow0[(size_t)(8 * grp + e) * NH + C_VA + h * 128 + dv]);
        v4u o; o.x = cvtpk(v[0], v[1]); o.y = cvtpk(v[2], v[3]); o.z = cvtpk(v[4], v[5]); o.w = cvtpk(v[6], v[7]);
        *(LAS v4u*)(VT + dv * 144 + grp * 16) = o;
    }
}
__device__ __forceinline__ void gla_local_item(Frame& F, int item) {
    const int bh = item >> 6, c = item & 63, b = bh >> 2, h = bh & 3;
    const int grp = F.wave, dcol = F.lane, lane = F.lane;
    LAS unsigned char* KhT = F.lds; LAS unsigned char* VT = F.lds + 9216; LAS float* TOT = (LAS float*)(F.lds + 27648);
    const bf16* Hrow0 = F.H + (size_t)(b * SEQ + 64 * c) * NH;
    float bc[8], blast;
    gla_cumsum(F, Hrow0, h, TOT, bc, blast);
    { float kh[8];
#pragma unroll
      for (int e = 0; e < 8; ++e) kh[e] = bf2f(Hrow0[(size_t)(8 * grp + e) * NH + C_KA + h * 64 + dcol]) * __expf(blast - bc[e]);
      v4u o; o.x = cvtpk(kh[0], kh[1]); o.y = cvtpk(kh[2], kh[3]); o.z = cvtpk(kh[4], kh[5]); o.w = cvtpk(kh[6], kh[7]);
      *(LAS v4u*)(KhT + dcol * 144 + grp * 16) = o; }
    gla_stage_vt(F, Hrow0, h, VT);
    if (grp == 0) F.DEC[item * 64 + dcol] = __expf(blast);
    __syncthreads();
    const int tr = F.wave >> 1, tc = F.wave & 1, l31 = lane & 31, hi = lane >> 5;
    f32x16 acc;
#pragma unroll
    for (int e = 0; e < 16; ++e) acc[e] = 0.f;
#pragma unroll
    for (int ks = 0; ks < 4; ++ks) {
        const bf16x8 a = *(const LAS bf16x8*)(VT + (32 * tr + l31) * 144 + ks * 32 + hi * 16);
        const bf16x8 bb = *(const LAS bf16x8*)(KhT + (32 * tc + l31) * 144 + ks * 32 + hi * 16);
        acc = __builtin_amdgcn_mfma_f32_32x32x16_bf16(a, bb, acc, 0, 0, 0);
    }
    float* Up = F.U + (size_t)item * 8192;
#pragma unroll
    for (int e = 0; e < 16; ++e) Up[(32 * tr + crow(e, hi)) * 64 + 32 * tc + l31] = acc[e];
    __syncthreads();
}
__device__ __forceinline__ void gla_scan(Frame& F) {
    const int bh = F.blk >> 4, part = F.blk & 15, e = part * 512 + F.tid, dk = e & 63, dv = e >> 6;
    float u[64];
#pragma unroll
    for (int c = 0; c < 64; ++c) u[c] = F.U[(size_t)(bh * 64 + c) * 8192 + e];
    float S = 0.f;
#pragma unroll
    for (int c = 0; c < 64; ++c) {
        F.SBT[(size_t)(bh * 64 + c) * 8192 + e] = f2bfs(S);
        S = F.DEC[(bh * 64 + c) * 64 + dk] * S + u[c];
    }
    F.out[O_SP + ((size_t)bh * 64 + dk) * 128 + dv] = S;
}
__device__ __forceinline__ void gla_out_item(Frame& F, int item) {
    const int bh = item >> 6, c = item & 63, b = bh >> 2, h = bh & 3;
    const int grp = F.wave, dcol = F.lane, lane = F.lane, tid = F.tid;
    LAS unsigned char* Qt = F.lds; LAS unsigned char* Kt = F.lds + 9216; LAS unsigned char* VT = F.lds + 18432; LAS unsigned char* ST = F.lds + 36864; LAS unsigned char* ATT = F.lds + 55296;
    LAS float* TOT = (LAS float*)(F.lds + 64512); LAS float* OF = (LAS float*)(F.lds + 66560);
    const size_t row0 = (size_t)(b * SEQ + 64 * c);
    const bf16* Hrow0 = F.H + row0 * NH;
    float bc[8], blast;
    gla_cumsum(F, Hrow0, h, TOT, bc, blast);
#pragma unroll
    for (int e = 0; e < 8; ++e) {
        const size_t ro = (size_t)(8 * grp + e) * NH + h * 64 + dcol;
        const float qv = bf2f(Hrow0[ro + C_QA]) * __expf(bc[e]);
        const float kv = bf2f(Hrow0[ro + C_KA]) * __expf(-bc[e]);
        *(LAS unsigned short*)(Qt + (8 * grp + e) * 144 + dcol * 2) = f2bfs(qv);
        *(LAS unsigned short*)(Kt + (8 * grp + e) * 144 + dcol * 2) = f2bfs(kv);
    }
    gla_stage_vt(F, Hrow0, h, VT);
    { const bf16* sp = F.SBT + (size_t)item * 8192;
#pragma unroll
      for (int i = 0; i < 2; ++i) { const int idx = tid + 512 * i, rr = idx >> 3, ch = idx & 7; *(LAS v4u*)(ST + rr * 144 + ch * 16) = *(const GAS v4u*)(sp + rr * 64 + ch * 8); } }
    __syncthreads();
    const int l31 = lane & 31, hi = lane >> 5;
    if (F.wave < 4) {
        const int tr = F.wave >> 1, tc = F.wave & 1;
        f32x16 acc;
#pragma unroll
        for (int e = 0; e < 16; ++e) acc[e] = 0.f;
#pragma unroll
        for (int ks = 0; ks < 4; ++ks) {
            const bf16x8 a = *(const LAS bf16x8*)(Qt + (32 * tr + l31) * 144 + ks * 32 + hi * 16);
            const bf16x8 bb = *(const LAS bf16x8*)(Kt + (32 * tc + l31) * 144 + ks * 32 + hi * 16);
            acc = __builtin_amdgcn_mfma_f32_32x32x16_bf16(a, bb, acc, 0, 0, 0);
        }
#pragma unroll
        for (int e = 0; e < 16; ++e) { const int t = 32 * tr + crow(e, hi), s = 32 * tc + l31; *(LAS unsigned short*)(ATT + t * 144 + s * 2) = f2bfs(s <= t ? acc[e] : 0.f); }
    }
    __syncthreads();
    {
        const int tr = F.wave >> 2, tc = F.wave & 3;
        f32x16 acc;
#pragma unroll
        for (int e = 0; e < 16; ++e) acc[e] = 0.f;
#pragma unroll
        for (int ks = 0; ks < 4; ++ks) {
            const bf16x8 a = *(const LAS bf16x8*)(ATT + (32 * tr + l31) * 144 + ks * 32 + hi * 16);
            const bf16x8 bb = *(const LAS bf16x8*)(VT + (32 * tc + l31) * 144 + ks * 32 + hi * 16);
            acc = __builtin_amdgcn_mfma_f32_32x32x16_bf16(a, bb, acc, 0, 0, 0);
        }
#pragma unroll
        for (int ks = 0; ks < 4; ++ks) {
            const bf16x8 a = *(const LAS bf16x8*)(Qt + (32 * tr + l31) * 144 + ks * 32 + hi * 16);
            const bf16x8 bb = *(const LAS bf16x8*)(ST + (32 * tc + l31) * 144 + ks * 32 + hi * 16);
            acc = __builtin_amdgcn_mfma_f32_32x32x16_bf16(a, bb, acc, 0, 0, 0);
        }
#pragma unroll
        for (int e = 0; e < 16; ++e) OF[(32 * tr + crow(e, hi)) * 132 + 32 * tc + l31] = acc[e];
    }
    __syncthreads();
    {
        const int t = tid >> 3, ch = tid & 7, dv0 = 16 * ch;
        float v[16]; float ss = 0.f;
#pragma unroll
        for (int i = 0; i < 4; ++i) { const f32x4 x = *(const LAS f32x4*)(OF + t * 132 + dv0 + 4 * i); v[4 * i] = x.x; v[4 * i + 1] = x.y; v[4 * i + 2] = x.z; v[4 * i + 3] = x.w; ss += x.x * x.x + x.y * x.y + x.z * x.z + x.w * x.w; }
        ss += __shfl_xor(ss, 1); ss += __shfl_xor(ss, 2); ss += __shfl_xor(ss, 4);
        const float rinv = 1.0f / sqrtf(ss * (1.f / 128.f) + RMS_EPS);
        const bf16* gp = F.H + (row0 + t) * NH + C_GA + h * 128 + dv0;
        const v4u g0 = *(const GAS v4u*)(gp), g1 = *(const GAS v4u*)(gp + 8);
        const unsigned gw[8] = {g0.x, g0.y, g0.z, g0.w, g1.x, g1.y, g1.z, g1.w};
        unsigned ow[8];
#pragma unroll
        for (int i = 0; i < 8; ++i) {
            const float a = v[2 * i] * rinv * F.gnorm[dv0 + 2 * i] * bflo(gw[i]);
            const float bq = v[2 * i + 1] * rinv * F.gnorm[dv0 + 2 * i + 1] * bfhi(gw[i]);
            ow[i] = cvtpk(a, bq);
        }
        bf16* mp = F.MIX + (row0 + t) * 1024 + h * 128 + dv0;
        *(GAS v4u*)(mp) = (v4u){ow[0], ow[1], ow[2], ow[3]}; *(GAS v4u*)(mp + 8) = (v4u){ow[4], ow[5], ow[6], ow[7]};
    }
    __syncthreads();
}

__device__ __forceinline__ void samp_gla_item(Frame& F, int item) {
    const int bs = item >> 2, h = item & 3, tid = F.tid;
    const int dkg = tid >> 7, dv = tid & 127;
    const bf16* Hr = F.H + (size_t)(MTOK + bs) * NH;
    LAS float* red = (LAS float*)F.lds;
    LAS float* red2 = red + 512;
    const float vv = bf2f(Hr[C_VA + h * 128 + dv]);
    float o = 0.f;
#pragma unroll
    for (int i = 0; i < 16; ++i) {
        const int dk = dkg * 16 + i;
        const float a = __expf(bf2f(Hr[C_GT + h * 64 + dk])), kk = bf2f(Hr[C_KA + h * 64 + dk]), qq = bf2f(Hr[C_QA + h * 64 + dk]);
        const size_t si = ((size_t)(bs * 4 + h) * 64 + dk) * 128 + dv;
        const float sn = a * F.state_gla[si] + kk * vv;
        F.out[O_SS + si] = sn;
        o += qq * sn;
    }
    red[dkg * 128 + dv] = o;
    __syncthreads();
    if (tid < 128) {
        const float ot = red[tid] + red[128 + tid] + red[256 + tid] + red[384 + tid];
        const float ss = wave_sum(ot * ot);
        if (F.lane == 0) red2[F.wave] = ss;
        red[tid] = ot;
    }
    __syncthreads();
    if (tid < 128) {
        const float ss = red2[0] + red2[1];
        const float rinv = 1.0f / sqrtf(ss * (1.f / 128.f) + RMS_EPS);
        F.MIX[(size_t)(MTOK + bs) * 1024 + h * 128 + tid] = f2bfs(red[tid] * rinv * F.gnorm[tid] * bf2f(Hr[C_GA + h * 128 + tid]));
    }
    __syncthreads();
}
__device__ __forceinline__ void samp_attn_item(Frame& F, int item) {
    const int bs = item >> 3, h = item & 7, w = F.wave, lane = F.lane;
    LAS float* lg = (LAS float*)F.lds;
    LAS float* part = lg + 392;
    const bf16* Hr = F.H + (size_t)(MTOK + bs) * NH;
    const int e = w * 49 + lane;
    const bool valid = (lane < 49) && (e < 387);
    if (valid) {
        const int p = e / 129, jj = e - p * 129, dist = jj << (2 * p);
        float dot = 0.f;
        if (dist == 0) {
#pragma unroll
            for (int c = 0; c < 8; ++c) { const v4u qw = *(const GAS v4u*)(Hr + C_QB + h * 64 + 8 * c), kw = *(const GAS v4u*)(Hr + C_KB + h * 64 + 8 * c);
                dot += bflo(qw.x) * bflo(kw.x) + bfhi(qw.x) * bfhi(kw.x) + bflo(qw.y) * bflo(kw.y) + bfhi(qw.y) * bfhi(kw.y) + bflo(qw.z) * bflo(kw.z) + bfhi(qw.z) * bfhi(kw.z) + bflo(qw.w) * bflo(kw.w) + bfhi(qw.w) * bfhi(kw.w); }
        } else {
            const float* kr = F.cache_k + (((size_t)bs * WPAST + (WPAST - dist)) * 8 + h) * 64;
#pragma unroll
            for (int c = 0; c < 8; ++c) { const v4u qw = *(const GAS v4u*)(Hr + C_QB + h * 64 + 8 * c); const f32x4 k0 = *(const GAS f32x4*)(kr + 8 * c), k1 = *(const GAS f32x4*)(kr + 8 * c + 4);
                dot += bflo(qw.x) * k0.x + bfhi(qw.x) * k0.y + bflo(qw.y) * k0.z + bfhi(qw.y) * k0.w + bflo(qw.z) * k1.x + bfhi(qw.z) * k1.y + bflo(qw.w) * k1.z + bfhi(qw.w) * k1.w; }
        }
        lg[e] = (dot + F.rel_bias[t5_bucket(dist) * 8 + h]) * LOG2E;
    }
    __syncthreads();
    float mx = -3e38f;
#pragma unroll
    for (int i = 0; i < 7; ++i) { const int ee = lane + 64 * i; if (ee < 387) mx = fmaxf(mx, lg[ee]); }
#pragma unroll
    for (int o = 1; o < 64; o <<= 1) mx = fmaxf(mx, __shfl_xor(mx, o));
    float sum = 0.f;
#pragma unroll
    for (int i = 0; i < 7; ++i) { const int ee = lane + 64 * i; if (ee < 387) sum += __builtin_amdgcn_exp2f(lg[ee] - mx); }
    sum = wave_sum(sum);
    float acc = 0.f;
    const float vnew = bf2f(Hr[C_VB + h * 64 + lane]);
#pragma unroll
    for (int i = 0; i < 49; ++i) {
        const int ee = w * 49 + i;
        if (ee < 387) {
            const int p = ee / 129, jj = ee - p * 129, dist = jj << (2 * p);
            const float pv = __builtin_amdgcn_exp2f(lg[ee] - mx);
            const float vv = (dist == 0) ? vnew : F.cache_v[(((size_t)bs * WPAST + (WPAST - (dist == 0 ? 1 : dist))) * 8 + h) * 64 + lane];
            acc += pv * vv;
        }
    }
    part[w * 64 + lane] = acc;
    __syncthreads();
    if (w == 0) {
        float tot = 0.f;
#pragma unroll
        for (int i = 0; i < 8; ++i) tot += part[i * 64 + lane];
        F.MIX[(size_t)(MTOK + bs) * 1024 + 512 + h * 64 + lane] = f2bfs(tot / sum * bf2f(Hr[C_GB + h * 64 + lane]));
    }
    __syncthreads();
}
__device__ __forceinline__ void samp_out_item(Frame& F, int item) {
    const int bs = item >> 3, cs = item & 7, lane = F.lane, w = F.wave;
    const bf16* mr = F.MIX + (size_t)(MTOK + bs) * 1024 + lane * 16;
    const v4u m0 = *(const GAS v4u*)(mr), m1 = *(const GAS v4u*)(mr + 8);
    float dots[16];
#pragma unroll
    for (int i = 0; i < 16; ++i) {
        const int dc = cs * 128 + w * 16 + i;
        const bf16* wr = F.WoT + (size_t)dc * 1024 + lane * 16;
        const v4u a0 = *(const GAS v4u*)(wr), a1 = *(const GAS v4u*)(wr + 8);
        dots[i] = bflo(m0.x) * bflo(a0.x) + bfhi(m0.x) * bfhi(a0.x) + bflo(m0.y) * bflo(a0.y) + bfhi(m0.y) * bfhi(a0.y) + bflo(m0.z) * bflo(a0.z) + bfhi(m0.z) * bfhi(a0.z) + bflo(m0.w) * bflo(a0.w) + bfhi(m0.w) * bfhi(a0.w)
                + bflo(m1.x) * bflo(a1.x) + bfhi(m1.x) * bfhi(a1.x) + bflo(m1.y) * bflo(a1.y) + bfhi(m1.y) * bfhi(a1.y) + bflo(m1.z) * bflo(a1.z) + bfhi(m1.z) * bfhi(a1.z) + bflo(m1.w) * bflo(a1.w) + bfhi(m1.w) * bfhi(a1.w);
    }
#pragma unroll
    for (int i = 0; i < 16; ++i) {
        const float t = wave_sum(dots[i]);
        const int dc = cs * 128 + w * 16 + i;
        if (lane == 0) F.YPRE[(size_t)(MTOK + bs) * 1024 + dc] = t + ALPHA * F.x_sample[bs * 1024 + dc];
    }
}
__device__ __forceinline__ void ln_rows(Frame& F) {
    const int gw = F.blk * NWAVES + F.wave, NGW = F.G * NWAVES;
    for (int m = gw; m < MTOK + NSAMP; m += NGW) {
        const GAS f32x4* xr = (const GAS f32x4*)(F.YPRE + (size_t)m * 1024) + F.lane;
        f32x4 v[4]; float s = 0.f;
#pragma unroll
        for (int j = 0; j < 4; ++j) { v[j] = xr[64 * j]; s += (v[j].x + v[j].y) + (v[j].z + v[j].w); }
        const float mean = wave_sum(s) * (1.f / 1024.f); float s2 = 0.f;
#pragma unroll
        for (int j = 0; j < 4; ++j) { v[j] = v[j] - mean; s2 += (v[j].x * v[j].x + v[j].y * v[j].y) + (v[j].z * v[j].z + v[j].w * v[j].w); }
        const float rstd = 1.0f / sqrtf(wave_sum(s2) * (1.f / 1024.f) + LN_EPS);
        GAS f32x4* o = (GAS f32x4*)(F.out + O_YP + (size_t)m * 1024) + F.lane;
#pragma unroll
        for (int j = 0; j < 4; ++j) { const f32x4 g = *((const GAS f32x4*)F.ln_g + F.lane + 64 * j), bb = *((const GAS f32x4*)F.ln_b + F.lane + 64 * j); o[64 * j] = v[j] * rstd * g + bb; }
    }
}

struct Args { const float* in[13]; float* out; unsigned char* ws; int ph_lo, ph_hi; };
__global__ void __launch_bounds__(NWAVES * 64, 2) hymba_fwd(Args args) {
    extern __shared__ __attribute__((aligned(16))) unsigned char lds[];
    Frame F;
    F.lds = (LAS unsigned char*)lds;
    F.MISC = (volatile LAS unsigned*)(F.lds + MISC_OFF);
    F.tid = threadIdx.x; F.lane = F.tid & 63; F.wave = __builtin_amdgcn_readfirstlane(F.tid >> 6);
    F.G = gridDim.x; F.blk = blockIdx.x;
    unsigned char* ws = args.ws;
    F.ctl = (gu32*)(ws + WS_CTL);
    F.x_prompt = args.in[0]; F.x_sample = args.in[1]; F.state_gla = args.in[2]; F.cache_k = args.in[3]; F.cache_v = args.in[4]; F.w_in = args.in[5]; F.w_alpha2 = args.in[6];
    F.b_alpha = args.in[7]; F.gnorm = args.in[8]; F.w_out = args.in[9]; F.ln_g = args.in[10]; F.ln_b = args.in[11]; F.rel_bias = args.in[12];
    F.out = args.out;
    F.WinT = (bf16*)(ws + WS_WIN); F.WoT = (bf16*)(ws + WS_WO); F.XB = (bf16*)(ws + WS_XB); F.H = (bf16*)(ws + WS_H); F.MIX = (bf16*)(ws + WS_MIX);
    F.SBT = (bf16*)(ws + WS_SBT); F.OP = (bf16*)(ws + WS_OP); F.U = (float*)(ws + WS_U); F.DEC = (float*)(ws + WS_DEC); F.MS = (float*)(ws + WS_MS); F.YPRE = (float*)(ws + WS_YPRE);
    for (int u = F.tid; u < (LDS_BYTES - LDSCTL_OFF) / 4; u += NWAVES * 64) ((LAS unsigned*)(F.lds + LDSCTL_OFF))[u] = 0u;
    __syncthreads();
    const int lo = args.ph_lo, hi = args.ph_hi;
    const bool one = (hi - lo) > 1;
    XcdBarrier bar; bar.bar = (unsigned*)(F.ctl + CW_BAR); bar.x = 0; bar.st = nullptr;
    if (one) bar = xcd_barrier_post((unsigned*)(F.ctl + CW_BAR), F.MISC + 8);
#define IN(k) (lo <= (k) && (k) < hi)
#define SEAM(k) do { if (IN(k) && IN((k) + 1)) xcd_barrier(bar); } while (0)

    if (IN(0)) { p0_prologue(F); } SEAM(0);
    if (IN(1)) {
        pg8::Gemm g{F.XB, F.WinT, MP, NH, DM}; pg8::StaticOrder S; S.init(MP, NH, F.G, F.blk);
        pg8::EpiInProj E{F.H, F.b_alpha, F.out + O_KP, F.out + O_VP, F.out + O_KS, F.out + O_VS};
        pg8::gemm_phase<pg8::EpiInProj, pg8::StaticOrder, true, true>(F.lds + RING_OFF, g, S, E);
    } SEAM(1);
    if (IN(2)) {
        for (int u = F.blk; u < 512; u += F.G) attn_unit<0>(F, u);
        for (int it = F.blk; it < 1024; it += F.G) gla_local_item(F, it);
        for (int it = F.blk; it < 256; it += F.G) samp_attn_item(F, it);
        for (int it = F.blk; it < 128; it += F.G) samp_gla_item(F, it);
    } SEAM(2);
    if (IN(3)) {
        for (int u = F.blk; u < 512; u += F.G) attn_unit<1>(F, u);
        if (F.blk < 256 && F.G >= 256) gla_scan(F);
    } SEAM(3);
    if (IN(4)) {
        for (int u = F.blk; u < 512; u += F.G) attn_unit<2>(F, u);
        for (int it = F.blk; it < 1024; it += F.G) gla_out_item(F, it);
    } SEAM(4);
    if (IN(5)) {
        pg8::Gemm g{F.MIX, F.WoT, MTOK, DM, DM}; pg8::StaticOrder S; S.init(MTOK, DM, F.G, F.blk);
        pg8::EpiYpre E{F.YPRE, F.x_prompt};
        pg8::gemm_phase<pg8::EpiYpre, pg8::StaticOrder, true, true>(F.lds + RING_OFF, g, S, E);
        for (int it = F.blk; it < 256; it += F.G) samp_out_item(F, it);
    } SEAM(5);
    if (IN(6)) { ln_rows(F); }
#undef IN
#undef SEAM
}

#ifndef MK_N_LAUNCHES
#define MK_N_LAUNCHES 1
#endif
extern "C" void kernel_launch(void* const* d_in, const int* in_sizes, int n_in, void* d_out, int out_size, void* d_ws, size_t ws_size, hipStream_t stream) {
    static int grid = 0;
    if (grid == 0) {
        if (n_in != 13 || out_size != (int)O_END || ws_size < WS_END) { fprintf(stderr, "kernel_launch: unexpected shapes: n_in %d out %d ws %zu; nothing launched\n", n_in, out_size, ws_size); grid = -1; return; }
        int dev = 0, cus = 0;
        if (hipGetDevice(&dev) != hipSuccess || hipDeviceGetAttribute(&cus, hipDeviceAttributeMultiprocessorCount, dev) != hipSuccess) { grid = -1; return; }
        if (hipFuncSetAttribute((const void*)hymba_fwd, hipFuncAttributeMaxDynamicSharedMemorySize, LDS_BYTES) != hipSuccess) { fprintf(stderr, "kernel_launch: hipFuncSetAttribute failed\n"); grid = -1; return; }
        (void)hipGetLastError();
        grid = cus;
        if (grid != 256) fprintf(stderr, "kernel_launch: %d CUs (built for 256)\n", grid);
    }
    if (grid < 0) return;
    (void)hipMemsetAsync((char*)d_ws + WS_CTL, 0, CTL_ZERO_BYTES, stream);
    Args a{};
    for (int i = 0; i < 13; ++i) a.in[i] = (const float*)d_in[i];
    a.out = (float*)d_out; a.ws = (unsigned char*)d_ws;
#if MK_N_LAUNCHES == 1
    a.ph_lo = 0; a.ph_hi = 7;
    hipLaunchKernelGGL(hymba_fwd, dim3(grid), dim3(NWAVES * 64), LDS_BYTES, stream, a);
#else
    for (int p = 0; p < 7; ++p) { a.ph_lo = p; a.ph_hi = p + 1; hipLaunchKernelGGL(hymba_fwd, dim3(grid), dim3(NWAVES * 64), LDS_BYTES, stream, a); }
#endif
}
```

```cpp
#include <hip/hip_runtime.h>
#include <cstdio>
#include <cstdint>
namespace pg8 {
#define PG8_LAS __attribute__((address_space(3)))
typedef unsigned short bf16_t;
typedef short bf16x8 __attribute__((ext_vector_type(8)));
typedef float f32x4 __attribute__((ext_vector_type(4)));
typedef unsigned u32x4 __attribute__((ext_vector_type(4)));
constexpr int BM = 256, BK = 64, HALF = 128, HTB = HALF * BK * 2  , STAGE_BYTES = 8 * HTB, NXCD = 8, WGM = 8;

__host__ __device__ __forceinline__ int lds_byte(int r, int c) { const int st = (r >> 4) * 2 + (c >> 5), rr = r & 15, cc = c & 31, ob = rr * 64 + cc * 2; return st * 1024 + (ob ^ (((ob >> 9) & 1) << 5)); }
__host__ __device__ __forceinline__ void stage_rc(int b, int& R, int& C) { const int st = b / 1024, sb = b % 1024, swz = sb ^ (((sb >> 9) & 1) << 5); R = (st >> 1) * 16 + swz / 64; C = (st & 1) * 32 + (swz % 64) / 2; }
__host__ __device__ __forceinline__ int perm32(int rho) { const int n = rho >> 4, i = rho & 15; return 8 * (i >> 2) + 4 * n + (i & 3); }

struct Unit { int pm, pn; };
struct Gemm { const bf16_t* A; const bf16_t* Bt; int M, N, K; };

struct StaticOrder {
    int nM, nN, nwg, G, c;
    __host__ __device__ void init(int M, int N, int G_, int c_) { nM = M / BM; nN = N / BM; nwg = nM * nN; G = G_; c = c_; }
    __host__ __device__ bool next(int i, Unit& u) const {
        const long L = (long)i * G + c; if (L >= nwg) return false;
        int wgid = (int)L; { const int q = nwg / NXCD, r = nwg % NXCD, xcd = wgid % NXCD, off = wgid / NXCD; wgid = (xcd < r ? xcd * (q + 1) : r * (q + 1) + (xcd - r) * q) + off; }
        const int nig = WGM * nN, gid = wgid / nig, fm = gid * WGM, gsz = (nM - fm) < WGM ? (nM - fm) : WGM;
        u.pm = fm + ((wgid % nig) % gsz); u.pn = (wgid % nig) / gsz; return true;
    }
    __device__ __forceinline__ void a_ready(const Unit&) const {}
    __device__ __forceinline__ void done(const Unit&) const {}
};

__device__ __forceinline__ unsigned cvt_pk_bf16(float lo, float hi) { unsigned r; asm volatile("v_cvt_pk_bf16_f32 %0, %1, %2" : "=v"(r) : "v"(lo), "v"(hi)); return r; }
typedef float f32x2 __attribute__((ext_vector_type(2)));
__device__ __forceinline__ f32x2 gelu_pk(f32x2 v) {
    const f32x2 av = __builtin_elementwise_abs(v), d = av * 0.2316418882f + 1.0f;
    f32x2 t; t.x = __builtin_amdgcn_rcpf(d.x); t.y = __builtin_amdgcn_rcpf(d.y);
    f32x2 q = t * 0.5307027145f + (-0.7265760135f); q = q * t + 0.7107068705f; q = q * t + (-0.142248368f); q = q * t + 0.127414796f; q = q * t;
    const f32x2 s = (v * v) * (-0.72134752044f);
    f32x2 e; e.x = __builtin_amdgcn_exp2f(s.x); e.y = __builtin_amdgcn_exp2f(s.y);
    const f32x2 m = v * (q * e), r = v - m;
    f32x2 o; o.x = v.x < 0.f ? m.x : r.x; o.y = v.y < 0.f ? m.y : r.y; return o;
}

template <int ACT  > struct EpiBf16 {
    static constexpr bool PERM = true, AFTER_DRAIN = false; static_assert(ACT == 0 || ACT == 1, "EpiBf16: ACT is 0 (none) or 1 (gelu_pk)");
    bf16_t* O; int ldc; const float* bias; int split_cols; size_t split_stride; float scale0;
    __device__ __forceinline__ void operator()(const f32x4 (&acc)[2][2][4][2], const Unit& u, int wr, int wc, int fr, int fq) const {
        const int row0 = u.pm * BM + wr * 64 + fr; int colt = u.pn * BM; bf16_t* base = O;
        float sc = 1.f; if (split_cols) { const int t = colt / split_cols; base += (size_t)t * split_stride; colt -= t * split_cols; if (t == 0) sc = scale0; }
        const int col0 = colt + wc * 32 + 8 * fq, bcol0 = u.pn * BM + wc * 32 + 8 * fq;
        f32x4 bv[2][2];
#pragma unroll
        for (int bj = 0; bj < 2; ++bj)
#pragma unroll
            for (int n = 0; n < 2; ++n) bv[bj][n] = bias ? *(const f32x4*)(bias + bcol0 + bj * HALF + 4 * n) : (f32x4){0.f, 0.f, 0.f, 0.f};
#pragma unroll
        for (int ai = 0; ai < 2; ++ai)
#pragma unroll
            for (int m = 0; m < 4; ++m) { bf16_t* rowp = base + (size_t)(row0 + ai * HALF + m * 16) * ldc + col0;
#pragma unroll
                for (int bj = 0; bj < 2; ++bj) { f32x4 v0 = acc[ai][bj][m][0] + bv[bj][0], v1 = acc[ai][bj][m][1] + bv[bj][1];
                    if (ACT == 1) { f32x2 a = gelu_pk((f32x2){v0[0], v0[1]}), b = gelu_pk((f32x2){v0[2], v0[3]}), c = gelu_pk((f32x2){v1[0], v1[1]}), d = gelu_pk((f32x2){v1[2], v1[3]});
                        v0 = (f32x4){a.x, a.y, b.x, b.y}; v1 = (f32x4){c.x, c.y, d.x, d.y}; }
                    v0 = v0 * sc; v1 = v1 * sc; u32x4 w; w.x = cvt_pk_bf16(v0[0], v0[1]); w.y = cvt_pk_bf16(v0[2], v0[3]); w.z = cvt_pk_bf16(v1[0], v1[1]); w.w = cvt_pk_bf16(v1[2], v1[3]);
                    *(u32x4*)(rowp + bj * HALF) = w; } }
    }
};

struct PanelStats {
    unsigned* xbuf;
    unsigned* cnt;
    unsigned* tmo;
    int ntn; float eps;
    unsigned code;
    __device__ __forceinline__ bool run(const f32x4 (&v)[2][2][4][2], const Unit& u, int wr, int wc, int fr, int fq, PG8_LAS unsigned char* lds, int wid, int lane) const {
        typedef float f32x2v __attribute__((ext_vector_type(2)));
        PG8_LAS f32x2v* P = (PG8_LAS f32x2v*)lds;
        PG8_LAS f32x2v* S = (PG8_LAS f32x2v*)(lds + 8192);
        PG8_LAS unsigned* flag = (PG8_LAS unsigned*)(lds + 8192 + 2048);
#pragma unroll
        for (int ai = 0; ai < 2; ++ai)
#pragma unroll
            for (int m = 0; m < 4; ++m) {
                float s = 0.f;
#pragma unroll
                for (int bj = 0; bj < 2; ++bj)
#pragma unroll
                    for (int n = 0; n < 2; ++n) { const f32x4 x = v[ai][bj][m][n]; s += (x[0] + x[1]) + (x[2] + x[3]); }
                s += __shfl_xor(s, 16); s += __shfl_xor(s, 32);
                const float mw = s * (1.0f / 64.0f); float q = 0.f;
#pragma unroll
                for (int bj = 0; bj < 2; ++bj)
#pragma unroll
                    for (int n = 0; n < 2; ++n) { const f32x4 d = v[ai][bj][m][n] - mw; q += (d[0] * d[0] + d[1] * d[1]) + (d[2] * d[2] + d[3] * d[3]); }
                q += __shfl_xor(q, 16); q += __shfl_xor(q, 32);
                if (fq == 0) P[(ai * HALF + wr * 64 + m * 16 + fr) * 4 + wc] = (f32x2v){mw, q};
            }
        asm volatile("s_waitcnt lgkmcnt(0)" ::: "memory"); __builtin_amdgcn_s_barrier(); asm volatile("" ::: "memory");
#if defined(BROKEN_EXCHANGE_NO_WAIT)
#warning BROKEN CONTROL BUILD: the row-statistics exchange does not wait; results are wrong by design
        if (blockIdx.x >= 64) { const long long t0_ = clock64(); while (clock64() - t0_ < 60000) __builtin_amdgcn_s_sleep(8); }
#endif
        const int row = wid * 32 + (lane & 31);
        if (lane < 32) {
            const f32x2v a = P[row * 4 + 0], b = P[row * 4 + 1], c = P[row * 4 + 2], d = P[row * 4 + 3];
            const float mt = (a.x + b.x + c.x + d.x) * 0.25f;
            const float da = a.x - mt, db = b.x - mt, dc = c.x - mt, dd = d.x - mt;
            const float m2 = (a.y + b.y) + (c.y + d.y) + 64.0f * ((da * da + db * db) + (dc * dc + dd * dd));
            unsigned long long* slot = (unsigned long long*)xbuf + ((size_t)(u.pm * BM + row) * 4 + u.pn);
            __hip_atomic_store(slot, ((unsigned long long)__float_as_uint(m2) << 32) | __float_as_uint(mt), __ATOMIC_RELAXED, __HIP_MEMORY_SCOPE_AGENT);
        }
        asm volatile("s_waitcnt vmcnt(0)" ::: "memory");
        if (lane == 0) __hip_atomic_fetch_add(cnt + 64 * u.pm, 1u, __ATOMIC_RELAXED, __HIP_MEMORY_SCOPE_AGENT);
        if (wid == 0) {
            bool dead = false; const unsigned long long t0 = __builtin_amdgcn_s_memrealtime(); const unsigned want = 8u * (unsigned)ntn;
            for (;;) {
#if defined(BROKEN_EXCHANGE_NO_WAIT)
                break;
#endif
                if ((unsigned)__builtin_amdgcn_readfirstlane(__hip_atomic_load(cnt + 64 * u.pm, __ATOMIC_RELAXED, __HIP_MEMORY_SCOPE_AGENT)) >= want) break;
                if (__builtin_amdgcn_s_memrealtime() - t0 > 2000000ull) {
                    if (lane == 0) { unsigned expect = 0u; __hip_atomic_compare_exchange_strong(tmo + 1, &expect, code | (unsigned)(u.pm & 0xff), __ATOMIC_RELAXED, __ATOMIC_RELAXED, __HIP_MEMORY_SCOPE_AGENT);
                                     __hip_atomic_store(tmo, 1u, __ATOMIC_RELAXED, __HIP_MEMORY_SCOPE_AGENT); }
                    dead = true; break; }
                __builtin_amdgcn_s_sleep(2);
            }
            __builtin_amdgcn_fence(__ATOMIC_ACQUIRE, "agent");
            if (lane == 0) flag[0] = dead ? 1u : 0u;
        }
        asm volatile("s_waitcnt vmcnt(0) lgkmcnt(0)" ::: "memory"); __builtin_amdgcn_s_barrier(); asm volatile("" ::: "memory");
        const bool bad = flag[0] != 0u;
        if (lane < 32) {
            const unsigned long long* slot = (const unsigned long long*)xbuf + (size_t)(u.pm * BM + row) * 4; float mt[4], m2[4]; float ms = 0.f;
#pragma unroll
            for (int t = 0; t < 4; ++t) { if (t < ntn) { const unsigned long long w = __hip_atomic_load(slot + t, __ATOMIC_RELAXED, __HIP_MEMORY_SCOPE_AGENT); mt[t] = __uint_as_float((unsigned)w); m2[t] = __uint_as_float((unsigned)(w >> 32)); } else { mt[t] = 0.f; m2[t] = 0.f; } ms += mt[t]; }
            const float mean = ms / (float)ntn; float q = 0.f;
#pragma unroll
            for (int t = 0; t < 4; ++t) if (t < ntn) { const float dm = mt[t] - mean; q += m2[t] + 256.0f * dm * dm; }
            S[row] = (f32x2v){mean, 1.0f / sqrtf(q / (256.0f * (float)ntn) + eps)};
        }
        asm volatile("s_waitcnt lgkmcnt(0)" ::: "memory"); __builtin_amdgcn_s_barrier(); asm volatile("" ::: "memory");
        return bad;
    }
};
struct EpiLnRes {
    static constexpr bool PERM = false, AFTER_DRAIN = true;
    const float* base; float* out; int ldc; const float* bias; PanelStats st; unsigned poison;
    __device__ __forceinline__ void fused(f32x4 (&acc)[2][2][4][2], const Unit& u, int wr, int wc, int fr, int fq, PG8_LAS unsigned char* lds, int wid, int lane) const {
        typedef float f32x2v __attribute__((ext_vector_type(2)));
        const PG8_LAS f32x2v* S = (const PG8_LAS f32x2v*)(lds + 8192);
        const int col0 = u.pn * BM + wc * 32 + 4 * fq;
#pragma unroll
        for (int bj = 0; bj < 2; ++bj)
#pragma unroll
            for (int n = 0; n < 2; ++n) { const f32x4 bv = bias ? *(const f32x4*)(bias + col0 + bj * HALF + n * 16) : (f32x4){0.f, 0.f, 0.f, 0.f};
#pragma unroll
                for (int ai = 0; ai < 2; ++ai)
#pragma unroll
                    for (int m = 0; m < 4; ++m) acc[ai][bj][m][n] += bv; }
        f32x4 pre[4][2][2];
#pragma unroll
        for (int m = 0; m < 4; ++m) { const size_t off = (size_t)(u.pm * BM + wr * 64 + m * 16 + fr) * ldc + col0;
#pragma unroll
            for (int bj = 0; bj < 2; ++bj)
#pragma unroll
                for (int n = 0; n < 2; ++n) pre[m][bj][n] = *(const f32x4*)(base + off + bj * HALF + n * 16); }
        const bool bad = st.run(acc, u, wr, wc, fr, fq, lds, wid, lane) || poison != 0u;
        const float qnan = __builtin_nanf("");
#pragma unroll
        for (int ai = 0; ai < 2; ++ai)
#pragma unroll
            for (int m = 0; m < 4; ++m) { const int r = ai * HALF + wr * 64 + m * 16 + fr; const f32x2v sr = S[r]; const size_t off = (size_t)(u.pm * BM + r) * ldc + col0;
#pragma unroll
                for (int bj = 0; bj < 2; ++bj)
#pragma unroll
                    for (int n = 0; n < 2; ++n) { const f32x4 bs = ai == 0 ? pre[m][bj][n] : *(const f32x4*)(base + off + bj * HALF + n * 16); f32x4 o = bs + (acc[ai][bj][m][n] - sr.x) * sr.y;
                        if (bad) o = (f32x4){qnan, qnan, qnan, qnan}; *(f32x4*)(out + off + bj * HALF + n * 16) = o; }
                if (m & 1) asm volatile("" ::: "memory"); }
    }
};
struct EpiLnResLn {
    static constexpr bool PERM = false, AFTER_DRAIN = true;
    const float* base; float* out; bf16_t* xn; int ldc; const float* bias; PanelStats st1, st2; unsigned poison;
    __device__ __forceinline__ void fused(f32x4 (&acc)[2][2][4][2], const Unit& u, int wr, int wc, int fr, int fq, PG8_LAS unsigned char* lds, int wid, int lane) const {
        typedef float f32x2v __attribute__((ext_vector_type(2))); typedef unsigned u32x2v __attribute__((ext_vector_type(2)));
        const PG8_LAS f32x2v* S = (const PG8_LAS f32x2v*)(lds + 8192);
        const int col0 = u.pn * BM + wc * 32 + 4 * fq;
#pragma unroll
        for (int bj = 0; bj < 2; ++bj)
#pragma unroll
            for (int n = 0; n < 2; ++n) { const f32x4 bv = bias ? *(const f32x4*)(bias + col0 + bj * HALF + n * 16) : (f32x4){0.f, 0.f, 0.f, 0.f};
#pragma unroll
                for (int ai = 0; ai < 2; ++ai)
#pragma unroll
                    for (int m = 0; m < 4; ++m) acc[ai][bj][m][n] += bv; }
        bool bad = st1.run(acc, u, wr, wc, fr, fq, lds, wid, lane) || poison != 0u;
        const float qnan = __builtin_nanf("");
#pragma unroll
        for (int ai = 0; ai < 2; ++ai)
#pragma unroll
            for (int m = 0; m < 4; ++m) { const int r = ai * HALF + wr * 64 + m * 16 + fr; const f32x2v sr = S[r]; const size_t off = (size_t)(u.pm * BM + r) * ldc + col0;
#pragma unroll
                for (int bj = 0; bj < 2; ++bj)
#pragma unroll
                    for (int n = 0; n < 2; ++n) { const f32x4 bs = *(const f32x4*)(base + off + bj * HALF + n * 16); acc[ai][bj][m][n] = bs + (acc[ai][bj][m][n] - sr.x) * sr.y; }
                asm volatile("" : "+v"(acc[ai][0][m][0]), "+v"(acc[ai][0][m][1]), "+v"(acc[ai][1][m][0]), "+v"(acc[ai][1][m][1]));
                if (m & 1) asm volatile("" ::: "memory"); }
        const bool bad1 = bad;
        bad = st2.run(acc, u, wr, wc, fr, fq, lds, wid, lane) || bad;
#pragma unroll
        for (int ai = 0; ai < 2; ++ai)
#pragma unroll
            for (int m = 0; m < 4; ++m) { const int r = ai * HALF + wr * 64 + m * 16 + fr; const f32x2v sr = S[r]; const size_t off = (size_t)(u.pm * BM + r) * ldc + col0;
#pragma unroll
                for (int bj = 0; bj < 2; ++bj)
#pragma unroll
                    for (int n = 0; n < 2; ++n) { const f32x4 x1 = acc[ai][bj][m][n]; *(f32x4*)(out + off + bj * HALF + n * 16) = bad1 ? (f32x4){qnan, qnan, qnan, qnan} : x1;
                        const f32x4 o = (x1 - sr.x) * sr.y; u32x2v w; w.x = cvt_pk_bf16(o[0], o[1]); w.y = cvt_pk_bf16(o[2], o[3]);
                        if (bad) { w.x = 0x7fc07fc0u; w.y = 0x7fc07fc0u; } *(u32x2v*)(xn + off + bj * HALF + n * 16) = w; }
                asm volatile("" ::: "memory"); }
    }
};

template <class Epi, class Sched, bool ALIGN_EPI = false, bool SP2 = false>
__device__ __forceinline__ void gemm_phase(PG8_LAS unsigned char* lds, const Gemm g, const Sched& S, const Epi& E) {
    const int tid = threadIdx.x, wid = __builtin_amdgcn_readfirstlane(tid >> 6), lane = tid & 63, wr = wid >> 2, wc = wid & 3, fr = lane & 15, fq = lane >> 4;
    const int K = g.K, nt = K / BK;
    unsigned voffA[2], voffB[2];
#pragma unroll
    for (int i = 0; i < 2; ++i) { int R, C; stage_rc(tid * 16 + i * 8192, R, C); const int Rb = Epi::PERM ? ((R & ~31) + perm32(R & 31)) : R;
        voffA[i] = (unsigned)(R * K + C) * 2u; voffB[i] = (unsigned)(Rb * K + C) * 2u; }
    const size_t kstep = (size_t)(BK * 2);
    const size_t hstep = (size_t)HALF * K * 2;
    const size_t tstep = 2 * hstep;
    const unsigned ldsw = (unsigned)wid * 1024u;
    const int aoff = lds_byte(wr * 64 + fr, fq * 8), boff = lds_byte(wc * 32 + fr, fq * 8);
#define PG8_SA(b, h) (((b) * 2 + (h)) * HTB)
#define PG8_SB(b, h) ((4 + (b) * 2 + (h)) * HTB)
#define PG8_STAGE(bufoff, gbase, voff) do { _Pragma("unroll") for (int _i = 0; _i < 2; ++_i) \
        __builtin_amdgcn_global_load_lds((const unsigned*)((const char*)(gbase) + (voff)[_i]), (PG8_LAS unsigned*)(lds + (bufoff) + ldsw + _i * 8192), 16, 0, 0); } while (0)
#define PG8_LDA(dst, b, h) do { _Pragma("unroll") for (int m = 0; m < 4; ++m) _Pragma("unroll") for (int k = 0; k < 2; ++k) dst[m][k] = *(const PG8_LAS bf16x8*)(lds + PG8_SA(b, h) + aoff + m * 2048 + k * 1024); } while (0)
#define PG8_LDB(dst, b, h) do { _Pragma("unroll") for (int n = 0; n < 2; ++n) _Pragma("unroll") for (int k = 0; k < 2; ++k) dst[n][k] = *(const PG8_LAS bf16x8*)(lds + PG8_SB(b, h) + boff + n * 2048 + k * 1024); } while (0)
#define PG8_MMA(ai, bj, At, Bt) do { __builtin_amdgcn_s_setprio(1); _Pragma("unroll") for (int m = 0; m < 4; ++m) _Pragma("unroll") for (int n = 0; n < 2; ++n) _Pragma("unroll") for (int k = 0; k < 2; ++k) \
        acc[ai][bj][m][n] = __builtin_amdgcn_mfma_f32_16x16x32_bf16(Bt[n][k], At[m][k], acc[ai][bj][m][n], 0, 0, 0); __builtin_amdgcn_s_setprio(0); } while (0)
#define PG8_WAIT_V(n) asm volatile("s_waitcnt vmcnt(" #n ")" ::: "memory")
#define PG8_WAIT_L(n) asm volatile("s_waitcnt lgkmcnt(" #n ")" ::: "memory")
#define PG8_BAR __builtin_amdgcn_s_barrier()
#define PG8_SCHED __builtin_amdgcn_sched_barrier(0)
    Unit cur, nxt; int ui = 0;
    if (!S.next(0, cur)) return;
    f32x4 acc[2][2][4][2];
#pragma unroll
    for (int a = 0; a < 2; ++a)
#pragma unroll
        for (int b = 0; b < 2; ++b)
#pragma unroll
            for (int m = 0; m < 4; ++m)
#pragma unroll
                for (int n = 0; n < 2; ++n) acc[a][b][m][n] = (f32x4){0.f, 0.f, 0.f, 0.f};
    bf16x8 At[4][2], B0[2][2], B1[2][2];
    const char* cA = (const char*)g.A + (size_t)cur.pm * tstep; const char* cB = (const char*)g.Bt + (size_t)cur.pn * tstep;
    S.a_ready(cur);
    if constexpr (SP2) {
        PG8_STAGE(PG8_SB(0, 0), cB, voffB); PG8_STAGE(PG8_SB(0, 1), cB + hstep, voffB); PG8_STAGE(PG8_SA(0, 0), cA, voffA); PG8_STAGE(PG8_SA(0, 1), cA + hstep, voffA);
        if (wr == 1) PG8_BAR;
        PG8_WAIT_V(2); PG8_BAR;
        PG8_STAGE(PG8_SB(1, 0), cB + kstep, voffB); PG8_STAGE(PG8_SA(1, 0), cA + kstep, voffA); PG8_STAGE(PG8_SB(1, 1), cB + hstep + kstep, voffB);
        PG8_WAIT_V(6); PG8_BAR;
    } else {
        PG8_STAGE(PG8_SB(0, 0), cB, voffB); PG8_STAGE(PG8_SA(0, 0), cA, voffA); PG8_STAGE(PG8_SB(0, 1), cB + hstep, voffB); PG8_STAGE(PG8_SA(0, 1), cA + hstep, voffA);
        if (wr == 1) PG8_BAR;
        PG8_WAIT_V(4); PG8_BAR;
        PG8_STAGE(PG8_SB(1, 0), cB + kstep, voffB); PG8_STAGE(PG8_SA(1, 0), cA + kstep, voffA); PG8_STAGE(PG8_SB(1, 1), cB + hstep + kstep, voffB);
        PG8_WAIT_V(6); PG8_BAR;
    }
    for (;;) {
        const bool has_next = S.next(ui + 1, nxt);
        const char* nA = has_next ? (const char*)g.A + (size_t)nxt.pm * tstep : cA; const char* nB = has_next ? (const char*)g.Bt + (size_t)nxt.pn * tstep : cB;
        for (int t = 0; t < nt; t += 2) {
            const bool last = (t == nt - 2);
            const char* a1 = cA + (size_t)(t + 1) * kstep;
            const char* a2 = last ? nA : cA + (size_t)(t + 2) * kstep; const char* b2 = last ? nB : cB + (size_t)(t + 2) * kstep;
            const char* a3 = a2 + kstep; const char* b3 = b2 + kstep;
            if (last && has_next) S.a_ready(nxt);
            if constexpr (SP2) {
            PG8_LDB(B0, 0, 0); PG8_LDB(B1, 0, 1); PG8_SCHED; PG8_LDA(At, 0, 0); PG8_STAGE(PG8_SA(1, 1), a1 + hstep, voffA);
            PG8_WAIT_V(8); PG8_WAIT_L(0); PG8_BAR; PG8_MMA(0, 0, At, B0); PG8_MMA(0, 1, At, B1); PG8_BAR; PG8_SCHED;
            PG8_LDA(At, 0, 1); PG8_STAGE(PG8_SB(0, 0), b2, voffB); PG8_STAGE(PG8_SB(0, 1), b2 + hstep, voffB); PG8_STAGE(PG8_SA(0, 0), a2, voffA);
            PG8_WAIT_V(8); PG8_WAIT_L(0); PG8_BAR; PG8_MMA(1, 0, At, B0); PG8_MMA(1, 1, At, B1); PG8_BAR; PG8_SCHED;
            PG8_LDB(B0, 1, 0); PG8_LDB(B1, 1, 1); PG8_SCHED; PG8_LDA(At, 1, 0); PG8_STAGE(PG8_SA(0, 1), a2 + hstep, voffA);
            PG8_WAIT_V(8); PG8_WAIT_L(0); PG8_BAR; PG8_MMA(0, 0, At, B0); PG8_MMA(0, 1, At, B1); PG8_BAR; PG8_SCHED;
            PG8_LDA(At, 1, 1); PG8_STAGE(PG8_SB(1, 0), b3, voffB); PG8_STAGE(PG8_SB(1, 1), b3 + hstep, voffB); PG8_STAGE(PG8_SA(1, 0), a3, voffA);
            PG8_WAIT_V(8); PG8_WAIT_L(0); PG8_BAR; PG8_MMA(1, 0, At, B0); PG8_MMA(1, 1, At, B1); PG8_BAR; PG8_SCHED;
            } else {
            PG8_LDB(B0, 0, 0); PG8_SCHED; PG8_LDA(At, 0, 0); PG8_STAGE(PG8_SA(1, 1), a1 + hstep, voffA);
            PG8_WAIT_L(8); PG8_BAR; PG8_WAIT_L(0); PG8_MMA(0, 0, At, B0); PG8_BAR; PG8_SCHED;
            PG8_LDB(B1, 0, 1); PG8_STAGE(PG8_SB(0, 0), b2, voffB);
            PG8_BAR; PG8_WAIT_L(0); PG8_MMA(0, 1, At, B1); PG8_BAR;
            PG8_LDA(At, 0, 1); PG8_STAGE(PG8_SA(0, 0), a2, voffA);
            PG8_BAR; PG8_WAIT_L(0); PG8_MMA(1, 0, At, B0); PG8_BAR; PG8_SCHED;
            PG8_STAGE(PG8_SB(0, 1), b2 + hstep, voffB);
            PG8_WAIT_V(6); PG8_BAR; PG8_MMA(1, 1, At, B1); PG8_BAR;
            PG8_LDB(B0, 1, 0); PG8_SCHED; PG8_LDA(At, 1, 0); PG8_STAGE(PG8_SA(0, 1), a2 + hstep, voffA);
            PG8_WAIT_L(8); PG8_BAR; PG8_WAIT_L(0); PG8_MMA(0, 0, At, B0); PG8_BAR; PG8_SCHED;
            PG8_LDB(B1, 1, 1); PG8_STAGE(PG8_SB(1, 0), b3, voffB);
            PG8_BAR; PG8_WAIT_L(0); PG8_MMA(0, 1, At, B1); PG8_BAR;
            PG8_LDA(At, 1, 1); PG8_STAGE(PG8_SA(1, 0), a3, voffA);
            PG8_BAR; PG8_WAIT_L(0); PG8_MMA(1, 0, At, B0); PG8_BAR; PG8_SCHED;
            PG8_STAGE(PG8_SB(1, 1), b3 + hstep, voffB);
            PG8_WAIT_V(6); PG8_BAR; PG8_MMA(1, 1, At, B1); PG8_BAR;
            }
        }
        if constexpr (ALIGN_EPI) { if (wr == 0) PG8_BAR; }
        if constexpr (!Epi::AFTER_DRAIN) { E(acc, cur, wr, wc, fr, fq); S.done(cur); }
        if (!has_next) break;
#pragma unroll
        for (int a = 0; a < 2; ++a)
#pragma unroll
            for (int b = 0; b < 2; ++b)
#pragma unroll
                for (int m = 0; m < 4; ++m)
#pragma unroll
                    for (int n = 0; n < 2; ++n) acc[a][b][m][n] = (f32x4){0.f, 0.f, 0.f, 0.f};
        cur = nxt; cA = nA; cB = nB; ++ui;
        if constexpr (ALIGN_EPI) { if (wr == 1) PG8_BAR; }
    }
    PG8_WAIT_V(0);
    if constexpr (!ALIGN_EPI) { if (wr == 0) PG8_BAR; }
    PG8_BAR;
    if constexpr (Epi::AFTER_DRAIN) { E.fused(acc, cur, wr, wc, fr, fq, lds, wid, lane); S.done(cur); }
#undef PG8_SA
#undef PG8_SB
#undef PG8_STAGE
#undef PG8_LDA
#undef PG8_LDB
#undef PG8_MMA
#undef PG8_WAIT_V
#undef PG8_WAIT_L
#undef PG8_BAR
#undef PG8_SCHED
}
}
#define GAS __attribute__((address_space(1)))
#define LAS __attribute__((address_space(3)))
typedef unsigned short bf16;
typedef unsigned v4u __attribute__((ext_vector_type(4)));
typedef float f32x4 __attribute__((ext_vector_type(4)));
typedef short bf16x8 __attribute__((ext_vector_type(8)));
typedef GAS unsigned gu32;
typedef GAS unsigned long long gu64;
#define RLX_AGENT __ATOMIC_RELAXED, __HIP_MEMORY_SCOPE_AGENT
#define LDS_WAIT() asm volatile("s_waitcnt lgkmcnt(0)" ::: "memory")
#define VM_WAIT() asm volatile("s_waitcnt vmcnt(0)" ::: "memory")
__device__ __forceinline__ unsigned long long rt() { return __builtin_amdgcn_s_memrealtime(); }
__device__ __forceinline__ unsigned f2bf(float f) { unsigned u = __builtin_bit_cast(unsigned, f); return (u + 0x7fffu + ((u >> 16) & 1u)) >> 16; }
__device__ __forceinline__ unsigned pk2(float lo, float hi) { return f2bf(lo) | (f2bf(hi) << 16); }

#define XB_TMO      128
#define XB_XCNT(j)  (256  + 64 * (j))
#define XB_XSUB(j)  (1280 + 64 * (j))
#define XB_XGEN(j)  (2304 + 64 * (j))
#define XB_TOP      3328
#define XB_TOPGEN   3392
#define XCD_BAR_WORDS 3456
#define XB_SPIN_CAP (1u << 18)

__device__ __forceinline__ unsigned xb_ld(unsigned* p)              { return __hip_atomic_load(p, __ATOMIC_RELAXED, __HIP_MEMORY_SCOPE_AGENT); }
__device__ __forceinline__ unsigned xb_add(unsigned* p, unsigned v) { return __hip_atomic_fetch_add(p, v, __ATOMIC_RELAXED, __HIP_MEMORY_SCOPE_AGENT); }
__device__ __forceinline__ unsigned xb_xcc_id() { return (unsigned)__builtin_amdgcn_s_getreg((3 << 11) | 20) & 0xFu; }
#define XB_SPIN(cond, bar) do { unsigned _sp = 0; while (cond) { __builtin_amdgcn_s_sleep(1); \
    if ((++_sp & 255u) == 0u) { if (xb_ld(&(bar)[XB_TMO])) break; if (_sp > XB_SPIN_CAP) { atomicAdd(&(bar)[XB_TMO], 1u); break; } } } } while (0)

struct XcdBarrier {
    unsigned* bar; unsigned x;
    volatile LAS unsigned* st;
};

__device__ __forceinline__ XcdBarrier xcd_barrier_post(unsigned* bar, volatile LAS unsigned* st) {
    XcdBarrier b; b.bar = bar; b.x = xb_xcc_id(); b.st = st;
    if (threadIdx.x == 0) (void)xb_add(&bar[XB_XCNT(b.x)], 1u);
    return b;
}
__device__ __forceinline__ void xcd_barrier_complete(unsigned* bar, unsigned x, unsigned& nloc, unsigned& nx) {
    const unsigned G = gridDim.x * gridDim.y * gridDim.z;
    unsigned sum, cnt, mine, sp = 0u;
    for (;;) {
        sum = 0u; cnt = 0u; mine = 0u;
#pragma unroll
        for (unsigned j = 0; j < 16; ++j) { const unsigned c = xb_ld(&bar[XB_XCNT(j)]); sum += c; cnt += (c > 0u) ? 1u : 0u; mine = (j == x) ? c : mine; }
        if (sum == G) break;
        __builtin_amdgcn_s_sleep(1);
        if ((++sp & 255u) == 0u) { if (xb_ld(&bar[XB_TMO])) break; if (sp > XB_SPIN_CAP) { atomicAdd(&bar[XB_TMO], 1u); break; } }
    }
    nloc = mine > 0u ? mine : 1u; nx = cnt > 0u ? cnt : 1u;
}

__device__ __forceinline__ void xcd_barrier(const XcdBarrier& b) {
    asm volatile("s_waitcnt vmcnt(0)" ::: "memory");
    __syncthreads();
    if (threadIdx.x == 0) {
        unsigned* bar = b.bar;
        __builtin_amdgcn_s_waitcnt(0);
        unsigned nloc = b.st[0], nx = b.st[1];
        if (nloc == 0u) { xcd_barrier_complete(bar, b.x, nloc, nx); b.st[0] = nloc; b.st[1] = nx; }
        const unsigned old = xb_add(&bar[XB_XSUB(b.x)], 1u);
        const unsigned gen = old / nloc;
        if (old + 1u == (gen + 1u) * nloc) {
            __builtin_amdgcn_fence(__ATOMIC_RELEASE, "agent");
            asm volatile("s_waitcnt vmcnt(0)" ::: "memory");
            const unsigned og = xb_add(&bar[XB_TOP], 1u);
            const unsigned tg = og / nx;
            if (og + 1u == (tg + 1u) * nx) xb_add(&bar[XB_TOPGEN], 1u);
            else XB_SPIN(xb_ld(&bar[XB_TOPGEN]) == tg, bar);
            __builtin_amdgcn_fence(__ATOMIC_ACQUIRE, "agent");
            xb_add(&bar[XB_XGEN(b.x)], 1u);
            asm volatile("s_waitcnt vmcnt(0)" ::: "memory");
        } else {
            XB_SPIN(xb_ld(&bar[XB_XGEN(b.x)]) == gen, bar);
            __builtin_amdgcn_fence(__ATOMIC_ACQUIRE, "agent");
            asm volatile("s_waitcnt vmcnt(0)" ::: "memory");
        }
    }
    __syncthreads();
}

constexpr int NWAVES = 8, NTHR = 512;
constexpr int DM = 1024, SEQ = 4096, NBATCH = 4, MTOK = NBATCH * SEQ, NSAMP = 32, MP = 16640;
constexpr int NH = 3840;
constexpr int DIN = 3600;
constexpr int C_QA = 0, C_KA = 256, C_VA = 512, C_GT = 1024, C_GA = 1280, C_QB = 1792, C_KB = 2304, C_VB = 2816, C_GB = 3328;
constexpr int WPAST = 2048;
constexpr float LOG2E = 1.4426950408889634f;
constexpr float ALPHA = 1.189207115002721f;
constexpr float LN_EPS = 1e-5f, RMS_EPS = 1e-6f;

constexpr size_t MiB = 1u << 20;
constexpr size_t WS_CTL = 0, CTL_ZERO_BYTES = 1 * MiB;
constexpr size_t WS_WIN = 2 * MiB;
constexpr size_t WS_WO = 10 * MiB;
constexpr size_t WS_XB = 12 * MiB;
constexpr size_t WS_H = 48 * MiB;
constexpr size_t WS_MIX = 172 * MiB;
constexpr size_t WS_U = 208 * MiB;
constexpr size_t WS_SBT = 240 * MiB;
constexpr size_t WS_DEC = 256 * MiB;
constexpr size_t WS_OP = 258 * MiB;
constexpr size_t WS_MS = 274 * MiB;
constexpr size_t WS_YPRE = 276 * MiB;
constexpr size_t WS_END = 342 * MiB;
constexpr int CW_BAR = 4096;

constexpr size_t O_YP = 0, O_YS = 16777216, O_SP = O_YS + 32768, O_SS = O_SP + 131072, O_KP = O_SS + 1048576, O_VP = O_KP + 4194304, O_KS = O_VP + 4194304, O_VS = O_KS + 16384, O_END = O_VS + 16384;

constexpr int RING_OFF = 0, RING_BYTES = 131072;
constexpr int LDSCTL_OFF = RING_BYTES, MISC_OFF = LDSCTL_OFF + 320;
constexpr int LDS_BYTES = 147456;

typedef float f32x16 __attribute__((ext_vector_type(16)));
typedef float f32x2_t __attribute__((ext_vector_type(2)));
typedef __bf16 bf16x2_t __attribute__((ext_vector_type(2)));
__device__ __forceinline__ unsigned cvtpk(float lo, float hi) { f32x2_t v = {lo, hi}; bf16x2_t b = __builtin_convertvector(v, bf16x2_t); return __builtin_bit_cast(unsigned, b); }
__device__ __forceinline__ unsigned short f2bfs(float f) { return (unsigned short)(cvtpk(f, 0.f) & 0xffffu); }
__device__ __forceinline__ float bf2f(unsigned short h) { return __uint_as_float(((unsigned)h) << 16); }
__device__ __forceinline__ float bflo(unsigned w) { return __uint_as_float(w << 16); }
__device__ __forceinline__ float bfhi(unsigned w) { return __uint_as_float(w & 0xffff0000u); }
__device__ __forceinline__ int crow(int r, int hi) { return (r & 3) + 8 * (r >> 2) + 4 * hi; }
__device__ __forceinline__ float wave_sum(float v) {
#pragma unroll
    for (int o = 1; o < 64; o <<= 1) v += __shfl_xor(v, o);
    return v;
}
__device__ __forceinline__ int t5_bucket(int dist) {
    if (dist < 16) return dist;
    const float d = (float)dist;
    const float lb = 16.f + logf(d / 16.f) / 4.852030263919617f * 16.f;
    const int b = (int)lb;
    return b < 31 ? b : 31;
}
__device__ __forceinline__ float logsig(float p) { const float e = __builtin_amdgcn_exp2f(-fabsf(p) * 1.4426950408889634f); return fminf(p, 0.f) - __builtin_amdgcn_logf(1.f + e) * 0.6931471805599453f; }
__device__ __forceinline__ float siluf(float v) { return v * __builtin_amdgcn_rcpf(1.f + __builtin_amdgcn_exp2f(-v * 1.4426950408889634f)); }

namespace pg8 {
struct EpiInProj {
    static constexpr bool PERM = true, AFTER_DRAIN = false;
    bf16_t* H; const float* b_alpha; float* kwp; float* vwp; float* kws; float* vws;
    __device__ __forceinline__ void operator()(const f32x4 (&acc)[2][2][4][2], const Unit& u, int wr, int wc, int fr, int fq) const {
        const int pn = u.pn;
        const int kind = (pn == 4) ? 1 : ((pn == 5 || pn == 6 || pn >= 13) ? 2 : ((pn >= 9 && pn <= 12) ? 3 : 0));
        const int row0 = u.pm * BM + wr * 64 + fr;
        const int col0 = pn * BM + wc * 32 + 8 * fq;
        f32x4 bv[2][2];
#pragma unroll
        for (int bj = 0; bj < 2; ++bj)
#pragma unroll
            for (int n = 0; n < 2; ++n) bv[bj][n] = (kind == 1) ? *(const f32x4*)(b_alpha + (col0 - 1024) + bj * HALF + 4 * n) : (f32x4){0.f, 0.f, 0.f, 0.f};
#pragma unroll
        for (int ai = 0; ai < 2; ++ai)
#pragma unroll
            for (int m = 0; m < 4; ++m) {
                const int row = row0 + ai * HALF + m * 16;
                bf16_t* rowp = H + (size_t)row * 3840 + col0;
                float* fdst = nullptr;
                if (kind == 3) {
                    const bool isv = (pn >= 11);
                    const int c = (pn - (isv ? 11 : 9)) * BM + wc * 32 + 8 * fq;
                    if (row < 16384) { const int t = row & 4095, b = row >> 12; if (t >= 2048) fdst = (isv ? vwp : kwp) + ((size_t)(b * 2048 + (t - 2048)) * 512 + c); }
                    else if (row < 16416) fdst = (isv ? vws : kws) + (size_t)(row - 16384) * 512 + c;
                }
#pragma unroll
                for (int bj = 0; bj < 2; ++bj) {
                    f32x4 v0 = acc[ai][bj][m][0], v1 = acc[ai][bj][m][1];
                    if (kind == 1) {
                        v0 = v0 + bv[bj][0]; v1 = v1 + bv[bj][1];
#pragma unroll
                        for (int e = 0; e < 4; ++e) { v0[e] = logsig(v0[e]) * 0.0625f; v1[e] = logsig(v1[e]) * 0.0625f; }
                    } else if (kind == 2) {
#pragma unroll
                        for (int e = 0; e < 4; ++e) { v0[e] = siluf(v0[e]); v1[e] = siluf(v1[e]); }
                    }
                    u32x4 w; w.x = cvt_pk_bf16(v0[0], v0[1]); w.y = cvt_pk_bf16(v0[2], v0[3]); w.z = cvt_pk_bf16(v1[0], v1[1]); w.w = cvt_pk_bf16(v1[2], v1[3]);
                    *(u32x4*)(rowp + bj * HALF) = w;
                    if (kind == 3 && fdst) { *(f32x4*)(fdst + bj * HALF) = v0; *(f32x4*)(fdst + bj * HALF + 4) = v1; }
                }
            }
    }
};
struct EpiYpre {
    static constexpr bool PERM = false, AFTER_DRAIN = false;
    float* Y; const float* x;
    __device__ __forceinline__ void operator()(const f32x4 (&acc)[2][2][4][2], const Unit& u, int wr, int wc, int fr, int fq) const {
        const int row0 = u.pm * BM + wr * 64 + fr, col0 = u.pn * BM + wc * 32 + 4 * fq;
#pragma unroll
        for (int ai = 0; ai < 2; ++ai)
#pragma unroll
            for (int m = 0; m < 4; ++m) {
                const size_t off = (size_t)(row0 + ai * HALF + m * 16) * 1024 + col0;
#pragma unroll
                for (int bj = 0; bj < 2; ++bj)
#pragma unroll
                    for (int n = 0; n < 2; ++n) { const f32x4 xv = *(const f32x4*)(x + off + bj * HALF + n * 16); *(f32x4*)(Y + off + bj * HALF + n * 16) = acc[ai][bj][m][n] + xv * 1.189207115002721f; }
            }
    }
};
}

struct Frame {
    LAS unsigned char* lds;
    volatile LAS unsigned* MISC;
    gu32* ctl;
    int tid, lane, wave, G, blk;
    const float *x_prompt, *x_sample, *state_gla, *cache_k, *cache_v, *w_in, *w_alpha2, *b_alpha, *gnorm, *w_out, *ln_g, *ln_b, *rel_bias;
    float* out;
    bf16 *WinT, *WoT, *XB, *H, *MIX, *SBT, *OP;
    float *U, *DEC, *MS, *YPRE;
};

__device__ __forceinline__ void p0_transpose(const float* W, int ldw, int srccol0, bf16* WT, int dstrow0, float scale, LAS float* scr, int kb, int lane) {
    const int k0 = 64 * kb;
#pragma unroll 8
    for (int i = 0; i < 32; ++i) { const int kk = 2 * i + (lane >> 5); scr[kk * 33 + (lane & 31)] = W[(size_t)(k0 + kk) * ldw + srccol0 + (lane & 31)]; }
    LDS_WAIT(); asm volatile("" ::: "memory");
    const int c = lane & 7;
#pragma unroll
    for (int j = 0; j < 4; ++j) { const int n = (lane >> 3) + 8 * j; const LAS float* s = scr + (8 * c) * 33 + n;
        v4u o; o.x = cvtpk(s[0 * 33] * scale, s[1 * 33] * scale); o.y = cvtpk(s[2 * 33] * scale, s[3 * 33] * scale); o.z = cvtpk(s[4 * 33] * scale, s[5 * 33] * scale); o.w = cvtpk(s[6 * 33] * scale, s[7 * 33] * scale);
        *(GAS v4u*)(WT + (size_t)(dstrow0 + n) * 1024 + k0 + 8 * c) = o; }
    LDS_WAIT(); asm volatile("" ::: "memory");
}
__device__ __forceinline__ void p0_prologue(Frame& F) {
    LAS float* scr = (LAS float*)(F.lds + RING_OFF + F.wave * 16384);
    const int gw = F.blk * NWAVES + F.wave, NGW = F.G * NWAVES;
    constexpr int I_WIN = 112 * 16, I_WO = 32 * 16, I_GT = 128, NITEMS = I_WIN + I_WO + I_GT;
    for (int it = gw; it < NITEMS; it += NGW) {
        int r = it;
        if (r < I_WIN) { const int ntile = r >> 4, kb = r & 15; const int nt = ntile < 32 ? ntile : ntile + 8; const int drow = 32 * nt; const int scol = drow < 1024 ? drow : drow - 240;
            const float sc = (drow < 256 || (drow >= C_QB && drow < C_KB)) ? 0.125f : 1.0f;
            p0_transpose(F.w_in, DIN, scol, F.WinT, drow, sc, scr, kb, F.lane); continue; }
        r -= I_WIN;
        if (r < I_WO) { const int nt = r >> 4, kb = r & 15; p0_transpose(F.w_out, 1024, 32 * nt, F.WoT, 32 * nt, 1.0f, scr, kb, F.lane); continue; }
        r -= I_WO;
        {
            const int kt = r & 15, jt = r >> 4; const int k = 64 * kt + F.lane;
            const float* zr = F.w_in + (size_t)k * DIN + 1024;
            f32x4 z[4];
#pragma unroll
            for (int i = 0; i < 4; ++i) z[i] = *(const GAS f32x4*)(zr + 4 * i);
            for (int jj = 0; jj < 32; ++jj) { const int j = 32 * jt + jj; float dot = 0.f;
#pragma unroll
                for (int rr = 0; rr < 16; ++rr) dot += z[rr >> 2][rr & 3] * F.w_alpha2[rr * 256 + j];
                F.WinT[(size_t)(1024 + j) * 1024 + k] = f2bfs(dot); }
        }
    }
    for (int m0 = gw; m0 < MP; m0 += 4 * NGW) {
        f32x4 v[4][4];
#pragma unroll
        for (int i = 0; i < 4; ++i) {
            const int m = m0 + i * NGW;
            if (m < MTOK + NSAMP) {
                const float* src = (m < MTOK) ? F.x_prompt + (size_t)m * 1024 : F.x_sample + (size_t)(m - MTOK) * 1024;
                const GAS f32x4* xr = (const GAS f32x4*)src + F.lane;
#pragma unroll
                for (int j = 0; j < 4; ++j) v[i][j] = xr[64 * j];
            } else {
#pragma unroll
                for (int j = 0; j < 4; ++j) v[i][j] = (f32x4){0.f, 0.f, 0.f, 0.f};
            }
        }
#pragma unroll
        for (int i = 0; i < 4; ++i) {
            const int m = m0 + i * NGW;
            if (m < MP) {
                GAS unsigned long long* o8 = (GAS unsigned long long*)(F.XB + (size_t)m * 1024) + F.lane;
#pragma unroll
                for (int j = 0; j < 4; ++j) o8[64 * j] = (unsigned long long)cvtpk(v[i][j].x, v[i][j].y) | ((unsigned long long)cvtpk(v[i][j].z, v[i][j].w) << 32);
            }
        }
    }
}

template <int PAT>
__device__ __forceinline__ void attn_unit(Frame& F, int u) {
    constexpr int d = (PAT == 0) ? 1 : ((PAT == 1) ? 4 : 16);
    const int tid = F.tid, lane = F.lane, w = F.wave;
    const int bh = u >> 4, rem = u & 15, r = rem % d, j = rem / d, b = bh >> 3, h = bh & 7;
    LAS unsigned char* Kl = F.lds; LAS unsigned char* VTl = F.lds + 55296;
    LAS float* tab = (LAS float*)(F.lds + 105984); LAS float* wsf = (LAS float*)(F.lds + 106752) + w * 128;
    const bf16* Hb = F.H + (size_t)b * SEQ * NH;
#pragma unroll
    for (int it = 0; it < 6; ++it) {
        const int idx = tid + 512 * it, kvrow = idx >> 3, c = idx & 7;
        const int ii = 256 * j - 128 + kvrow;
        if (ii >= 0) {
            const bf16* rowp = Hb + (size_t)(r + d * ii) * NH + h * 64 + c * 8;
            const v4u kk = *(const GAS v4u*)(rowp + C_KB), vv = *(const GAS v4u*)(rowp + C_VB);
            *(LAS v4u*)(Kl + kvrow * 144 + c * 16) = kk;
            LAS unsigned short* vt = (LAS unsigned short*)(VTl + (8 * c) * 792 + kvrow * 2);
            vt[0 * 396] = (unsigned short)(vv.x & 0xffffu); vt[1 * 396] = (unsigned short)(vv.x >> 16);
            vt[2 * 396] = (unsigned short)(vv.y & 0xffffu); vt[3 * 396] = (unsigned short)(vv.y >> 16);
            vt[4 * 396] = (unsigned short)(vv.z & 0xffffu); vt[5 * 396] = (unsigned short)(vv.z >> 16);
            vt[6 * 396] = (unsigned short)(vv.w & 0xffffu); vt[7 * 396] = (unsigned short)(vv.w >> 16);
        }
    }
    if (tid < 192) { const int ds = tid - 32; float v = -1e30f; if (ds >= 0 && ds <= 128) v = F.rel_bias[t5_bucket(d * ds) * 8 + h] * LOG2E; tab[tid] = v; }
    const int q = lane & 31, hi = lane >> 5;
    const int iq = 256 * j + 32 * w + q;
    const size_t growq = (size_t)b * SEQ + r + d * iq;
    bf16x8 qf[4];
    { const bf16* qp = F.H + growq * NH + C_QB + h * 64 + hi * 8;
#pragma unroll
      for (int ks = 0; ks < 4; ++ks) qf[ks] = *(const GAS bf16x8*)(qp + ks * 16); }
    float* msp = F.MS + (growq * 8 + h) * 2;
    float mp_prev = 0.f, sp_prev = 0.f;
    if (PAT >= 1) { mp_prev = msp[0]; sp_prev = msp[1]; }
    const int dcol = lane & 31;
    const int erow = lane >> 3, ech = lane & 7;
    v4u pvr[4];
    if (PAT >= 1) {
#pragma unroll
        for (int i = 0; i < 4; ++i) { const unsigned grow = (unsigned)(b * SEQ + r + d * (256 * j + 32 * w + erow + 8 * i)); pvr[i] = *(const GAS v4u*)(F.OP + (size_t)grow * 512 + h * 64 + ech * 8); }
    }
    __syncthreads();
    const int kt_lo = (j == 0) ? (w > 4 ? w : 4) : w;
    f32x16 X[5];
    float mx = -3e38f;
#pragma unroll
    for (int tt = 0; tt < 5; ++tt) {
        const int kt = w + tt;
        if (kt >= kt_lo) {
            f32x16 acc;
#pragma unroll
            for (int e = 0; e < 16; ++e) acc[e] = 0.f;
            const LAS unsigned char* kp = Kl + (kt * 32 + q) * 144 + hi * 16;
#pragma unroll
            for (int ks = 0; ks < 4; ++ks) acc = __builtin_amdgcn_mfma_f32_32x32x16_bf16(*(const LAS bf16x8*)(kp + ks * 32), qf[ks], acc, 0, 0, 0);
            const LAS float* tp = tab + (160 - 32 * tt + q - 4 * hi);
#pragma unroll
            for (int e = 0; e < 16; ++e) { const int kvo = (e & 3) + 8 * (e >> 2); const float v = acc[e] * LOG2E + tp[-kvo]; acc[e] = v; mx = fmaxf(mx, v); }
            X[tt] = acc;
        } else {
#pragma unroll
            for (int e = 0; e < 16; ++e) X[tt][e] = 0.f;
        }
    }
    mx = fmaxf(mx, __shfl_xor(mx, 32));
    float sum = 0.f;
#pragma unroll
    for (int tt = 0; tt < 5; ++tt) {
        if (w + tt >= kt_lo) {
#pragma unroll
            for (int e = 0; e < 16; ++e) { const float p = __builtin_amdgcn_exp2f(X[tt][e] - mx); X[tt][e] = p; sum += p; }
        }
    }
    sum += __shfl_xor(sum, 32);
    f32x16 o0, o1;
#pragma unroll
    for (int e = 0; e < 16; ++e) { o0[e] = 0.f; o1[e] = 0.f; }
#pragma unroll
    for (int tt = 0; tt < 5; ++tt) {
        if (w + tt >= kt_lo) {
#pragma unroll
            for (int s2 = 0; s2 < 2; ++s2) {
                v4u pw; pw.x = cvtpk(X[tt][8 * s2 + 0], X[tt][8 * s2 + 1]); pw.y = cvtpk(X[tt][8 * s2 + 2], X[tt][8 * s2 + 3]); pw.z = cvtpk(X[tt][8 * s2 + 4], X[tt][8 * s2 + 5]); pw.w = cvtpk(X[tt][8 * s2 + 6], X[tt][8 * s2 + 7]);
                const bf16x8 pa = __builtin_bit_cast(bf16x8, pw);
                const int kvb = (w + tt) * 32 + 16 * s2 + 4 * hi;
                const LAS unsigned char* vp = VTl + dcol * 792 + kvb * 2;
                typedef unsigned long long u64x2 __attribute__((ext_vector_type(2)));
                u64x2 b0, b1;
                b0.x = *(const LAS unsigned long long*)(vp); b0.y = *(const LAS unsigned long long*)(vp + 16);
                b1.x = *(const LAS unsigned long long*)(vp + 32 * 792); b1.y = *(const LAS unsigned long long*)(vp + 32 * 792 + 16);
                o0 = __builtin_amdgcn_mfma_f32_32x32x16_bf16(pa, __builtin_bit_cast(bf16x8, b0), o0, 0, 0, 0);
                o1 = __builtin_amdgcn_mfma_f32_32x32x16_bf16(pa, __builtin_bit_cast(bf16x8, b1), o1, 0, 0, 0);
            }
        }
    }
    float fc, fp = 0.f;
    if (PAT == 0) { fc = 1.f / sum; if (hi == 0) { msp[0] = mx; msp[1] = sum; } }
    else {
        const float mn = fmaxf(mp_prev, mx); const float a = sp_prev * __builtin_amdgcn_exp2f(mp_prev - mn), c = __builtin_amdgcn_exp2f(mx - mn);
        const float sn = a + c * sum, inv = 1.f / sn;
        fp = a * inv; fc = c * inv;
        if (PAT == 1 && hi == 0) { msp[0] = mn; msp[1] = sn; }
    }
    if (hi == 0) { wsf[q] = fc; wsf[32 + q] = fp; }
    v4u gvr[4];
    if (PAT == 2) {
#pragma unroll
        for (int i = 0; i < 4; ++i) { const unsigned grow = (unsigned)(b * SEQ + r + d * (256 * j + 32 * w + erow + 8 * i)); gvr[i] = *(const GAS v4u*)(F.H + (size_t)grow * NH + C_GB + h * 64 + ech * 8); }
    }
    __syncthreads();
    LAS float* stg = (LAS float*)F.lds + w * (32 * 68);
#pragma unroll
    for (int e = 0; e < 16; ++e) { const int qrow = crow(e, hi); stg[qrow * 68 + dcol] = o0[e]; stg[qrow * 68 + 32 + dcol] = o1[e]; }
    asm volatile("s_waitcnt lgkmcnt(0)" ::: "memory");
#pragma unroll
    for (int i = 0; i < 4; ++i) {
        const int row = erow + 8 * i;
        const f32x4 a0 = *(const LAS f32x4*)(stg + row * 68 + ech * 8), a1 = *(const LAS f32x4*)(stg + row * 68 + ech * 8 + 4);
        const float fcr = wsf[row], fpr = wsf[32 + row];
        float v[8] = {a0.x * fcr, a0.y * fcr, a0.z * fcr, a0.w * fcr, a1.x * fcr, a1.y * fcr, a1.z * fcr, a1.w * fcr};
        if (PAT >= 1) {
            v[0] += bflo(pvr[i].x) * fpr; v[1] += bfhi(pvr[i].x) * fpr; v[2] += bflo(pvr[i].y) * fpr; v[3] += bfhi(pvr[i].y) * fpr;
            v[4] += bflo(pvr[i].z) * fpr; v[5] += bfhi(pvr[i].z) * fpr; v[6] += bflo(pvr[i].w) * fpr; v[7] += bfhi(pvr[i].w) * fpr;
        }
        const unsigned grow = (unsigned)(b * SEQ + r + d * (256 * j + 32 * w + row));
        if (PAT < 2) {
            v4u o; o.x = cvtpk(v[0], v[1]); o.y = cvtpk(v[2], v[3]); o.z = cvtpk(v[4], v[5]); o.w = cvtpk(v[6], v[7]);
            *(GAS v4u*)(F.OP + (size_t)grow * 512 + h * 64 + ech * 8) = o;
        } else {
            v4u o; o.x = cvtpk(v[0] * bflo(gvr[i].x), v[1] * bfhi(gvr[i].x)); o.y = cvtpk(v[2] * bflo(gvr[i].y), v[3] * bfhi(gvr[i].y));
            o.z = cvtpk(v[4] * bflo(gvr[i].z), v[5] * bfhi(gvr[i].z)); o.w = cvtpk(v[6] * bflo(gvr[i].w), v[7] * bfhi(gvr[i].w));
            *(GAS v4u*)(F.MIX + (size_t)grow * 1024 + 512 + h * 64 + ech * 8) = o;
        }
    }
    __syncthreads();
}

__device__ __forceinline__ void gla_cumsum(Frame& F, const bf16* Hrow0, int h, LAS float* TOT, float (&bc)[8], float& blast) {
    const int grp = F.wave, dcol = F.lane;
    float run = 0.f;
#pragma unroll
    for (int e = 0; e < 8; ++e) { run += bf2f(Hrow0[(size_t)(8 * grp + e) * NH + C_GT + h * 64 + dcol]); bc[e] = run; }
    TOT[grp * 64 + dcol] = run;
    __syncthreads();
    float pre = 0.f, tot = 0.f;
#pragma unroll
    for (int g = 0; g < 8; ++g) { const float t = TOT[g * 64 + dcol]; tot += t; if (g < grp) pre += t; }
#pragma unroll
    for (int e = 0; e < 8; ++e) bc[e] += pre;
    blast = tot;
}
__device__ __forceinline__ void gla_stage_vt(Frame& F, const bf16* Hrow0, int h, LAS unsigned char* VT) {
    const int grp = F.wave, dcol = F.lane;
#pragma unroll
    for (int half = 0; half < 2; ++half) {
        const int dv = dcol + 64 * half; float v[8];
#pragma unroll
        for (int e = 0; e < 8; ++e) v[e] = bf2f(Hrow0[(size_t)(8 * grp + e) * NH + C_VA + h * 128 + dv]);
        v4u o; o.x = cvtpk(v[0], v[1]); o.y = cvtpk(v[2], v[3]); o.z = cvtpk(v[4], v[5]); o.w = cvtpk(v[6], v[7]);
        *(LAS v4u*)(VT + dv * 144 + grp * 16) = o;
    }
}
__device__ __forceinline__ void gla_local_item(Frame& F, int item) {
    const int bh = item >> 6, c = item & 63, b = bh >> 2, h = bh & 3;
    const int grp = F.wave, dcol = F.lane, lane = F.lane;
    LAS unsigned char* KhT = F.lds; LAS unsigned char* VT = F.lds + 9216; LAS float* TOT = (LAS float*)(F.lds + 27648);
    const bf16* Hrow0 = F.H + (size_t)(b * SEQ + 64 * c) * NH;
    float bc[8], blast;
    gla_cumsum(F, Hrow0, h, TOT, bc, blast);
    { float kh[8];
#pragma unroll
      for (int e = 0; e < 8; ++e) kh[e] = bf2f(Hrow0[(size_t)(8 * grp + e) * NH + C_KA + h * 64 + dcol]) * __expf(blast - bc[e]);
      v4u o; o.x = cvtpk(kh[0], kh[1]); o.y = cvtpk(kh[2], kh[3]); o.z = cvtpk(kh[4], kh[5]); o.w = cvtpk(kh[6], kh[7]);
      *(LAS v4u*)(KhT + dcol * 144 + grp * 16) = o; }
    gla_stage_vt(F, Hrow0, h, VT);
    if (grp == 0) F.DEC[item * 64 + dcol] = __expf(blast);
    __syncthreads();
    const int tr = F.wave >> 1, tc = F.wave & 1, l31 = lane & 31, hi = lane >> 5;
    f32x16 acc;
#pragma unroll
    for (int e = 0; e < 16; ++e) acc[e] = 0.f;
#pragma unroll
    for (int ks = 0; ks < 4; ++ks) {
        const bf16x8 a = *(const LAS bf16x8*)(VT + (32 * tr + l31) * 144 + ks * 32 + hi * 16);
        const bf16x8 bb = *(const LAS bf16x8*)(KhT + (32 * tc + l31) * 144 + ks * 32 + hi * 16);
        acc = __builtin_amdgcn_mfma_f32_32x32x16_bf16(a, bb, acc, 0, 0, 0);
    }
    float* Up = F.U + (size_t)item * 8192;
#pragma unroll
    for (int e = 0; e < 16; ++e) Up[(32 * tr + crow(e, hi)) * 64 + 32 * tc + l31] = acc[e];
    __syncthreads();
}
__device__ __forceinline__ void gla_scan(Frame& F) {
    const int bh = F.blk >> 4, part = F.blk & 15, e = part * 512 + F.tid, dk = e & 63, dv = e >> 6;
    float u[64];
#pragma unroll
    for (int c = 0; c < 64; ++c) u[c] = F.U[(size_t)(bh * 64 + c) * 8192 + e];
    float dec[64];
#pragma unroll
    for (int c = 0; c < 64; ++c) dec[c] = F.DEC[(bh * 64 + c) * 64 + dk];
    float S = 0.f;
#pragma unroll
    for (int c = 0; c < 64; ++c) {
        F.SBT[(size_t)(bh * 64 + c) * 8192 + e] = f2bfs(S);
        S = dec[c] * S + u[c];
    }
    F.out[O_SP + ((size_t)bh * 64 + dk) * 128 + dv] = S;
}
__device__ __forceinline__ void gla_out_item(Frame& F, int item) {
    const int bh = item >> 6, c = item & 63, b = bh >> 2, h = bh & 3;
    const int grp = F.wave, dcol = F.lane, lane = F.lane, tid = F.tid;
    LAS unsigned char* Qt = F.lds; LAS unsigned char* Kt = F.lds + 9216; LAS unsigned char* VT = F.lds + 18432; LAS unsigned char* ST = F.lds + 36864; LAS unsigned char* ATT = F.lds + 55296;
    LAS float* TOT = (LAS float*)(F.lds + 64512); LAS float* OF = (LAS float*)(F.lds + 66560);
    const size_t row0 = (size_t)(b * SEQ + 64 * c);
    const bf16* Hrow0 = F.H + row0 * NH;
    float bc[8], blast;
    gla_cumsum(F, Hrow0, h, TOT, bc, blast);
#pragma unroll
    for (int e = 0; e < 8; ++e) {
        const size_t ro = (size_t)(8 * grp + e) * NH + h * 64 + dcol;
        const float qv = bf2f(Hrow0[ro + C_QA]) * __expf(bc[e]);
        const float kv = bf2f(Hrow0[ro + C_KA]) * __expf(-bc[e]);
        *(LAS unsigned short*)(Qt + (8 * grp + e) * 144 + dcol * 2) = f2bfs(qv);
        *(LAS unsigned short*)(Kt + (8 * grp + e) * 144 + dcol * 2) = f2bfs(kv);
    }
    gla_stage_vt(F, Hrow0, h, VT);
    { const bf16* sp = F.SBT + (size_t)item * 8192;
#pragma unroll
      for (int i = 0; i < 2; ++i) { const int idx = tid + 512 * i, rr = idx >> 3, ch = idx & 7; *(LAS v4u*)(ST + rr * 144 + ch * 16) = *(const GAS v4u*)(sp + rr * 64 + ch * 8); } }
    __syncthreads();
    const int l31 = lane & 31, hi = lane >> 5;
    if (F.wave < 4) {
        const int tr = F.wave >> 1, tc = F.wave & 1;
        f32x16 acc;
#pragma unroll
        for (int e = 0; e < 16; ++e) acc[e] = 0.f;
#pragma unroll
        for (int ks = 0; ks < 4; ++ks) {
            const bf16x8 a = *(const LAS bf16x8*)(Qt + (32 * tr + l31) * 144 + ks * 32 + hi * 16);
            const bf16x8 bb = *(const LAS bf16x8*)(Kt + (32 * tc + l31) * 144 + ks * 32 + hi * 16);
            acc = __builtin_amdgcn_mfma_f32_32x32x16_bf16(a, bb, acc, 0, 0, 0);
        }
#pragma unroll
        for (int e = 0; e < 16; ++e) { const int t = 32 * tr + crow(e, hi), s = 32 * tc + l31; *(LAS unsigned short*)(ATT + t * 144 + s * 2) = f2bfs(s <= t ? acc[e] : 0.f); }
    }
    __syncthreads();
    {
        const int tr = F.wave >> 2, tc = F.wave & 3;
        f32x16 acc;
#pragma unroll
        for (int e = 0; e < 16; ++e) acc[e] = 0.f;
#pragma unroll
        for (int ks = 0; ks < 4; ++ks) {
            const bf16x8 a = *(const LAS bf16x8*)(ATT + (32 * tr + l31) * 144 + ks * 32 + hi * 16);
            const bf16x8 bb = *(const LAS bf16x8*)(VT + (32 * tc + l31) * 144 + ks * 32 + hi * 16);
            acc = __builtin_amdgcn_mfma_f32_32x32x16_bf16(a, bb, acc, 0, 0, 0);
        }
#pragma unroll
        for (int ks = 0; ks < 4; ++ks) {
            const bf16x8 a = *(const LAS bf16x8*)(Qt + (32 * tr + l31) * 144 + ks * 32 + hi * 16);
            const bf16x8 bb = *(const LAS bf16x8*)(ST + (32 * tc + l31) * 144 + ks * 32 + hi * 16);
            acc = __builtin_amdgcn_mfma_f32_32x32x16_bf16(a, bb, acc, 0, 0, 0);
        }
#pragma unroll
        for (int e = 0; e < 16; ++e) OF[(32 * tr + crow(e, hi)) * 132 + 32 * tc + l31] = acc[e];
    }
    __syncthreads();
    {
        const int t = tid >> 3, ch = tid & 7, dv0 = 16 * ch;
        float v[16]; float ss = 0.f;
#pragma unroll
        for (int i = 0; i < 4; ++i) { const f32x4 x = *(const LAS f32x4*)(OF + t * 132 + dv0 + 4 * i); v[4 * i] = x.x; v[4 * i + 1] = x.y; v[4 * i + 2] = x.z; v[4 * i + 3] = x.w; ss += x.x * x.x + x.y * x.y + x.z * x.z + x.w * x.w; }
        ss += __shfl_xor(ss, 1); ss += __shfl_xor(ss, 2); ss += __shfl_xor(ss, 4);
        const float rinv = 1.0f / sqrtf(ss * (1.f / 128.f) + RMS_EPS);
        const bf16* gp = F.H + (row0 + t) * NH + C_GA + h * 128 + dv0;
        const v4u g0 = *(const GAS v4u*)(gp), g1 = *(const GAS v4u*)(gp + 8);
        const unsigned gw[8] = {g0.x, g0.y, g0.z, g0.w, g1.x, g1.y, g1.z, g1.w};
        unsigned ow[8];
#pragma unroll
        for (int i = 0; i < 8; ++i) {
            const float a = v[2 * i] * rinv * F.gnorm[dv0 + 2 * i] * bflo(gw[i]);
            const float bq = v[2 * i + 1] * rinv * F.gnorm[dv0 + 2 * i + 1] * bfhi(gw[i]);
            ow[i] = cvtpk(a, bq);
        }
        bf16* mp = F.MIX + (row0 + t) * 1024 + h * 128 + dv0;
        *(GAS v4u*)(mp) = (v4u){ow[0], ow[1], ow[2], ow[3]}; *(GAS v4u*)(mp + 8) = (v4u){ow[4], ow[5], ow[6], ow[7]};
    }
    __syncthreads();
}

__device__ __forceinline__ void samp_gla_item(Frame& F, int item) {
    const int bs = item >> 2, h = item & 3, tid = F.tid;
    const int dkg = tid >> 7, dv = tid & 127;
    const bf16* Hr = F.H + (size_t)(MTOK + bs) * NH;
    LAS float* red = (LAS float*)F.lds;
    LAS float* red2 = red + 512;
    const float vv = bf2f(Hr[C_VA + h * 128 + dv]);
    float o = 0.f;
    float so[16], ga_[16], kk_[16], qq_[16];
#pragma unroll
    for (int i = 0; i < 16; ++i) {
        const int dk = dkg * 16 + i;
        so[i] = F.state_gla[((size_t)(bs * 4 + h) * 64 + dk) * 128 + dv];
        ga_[i] = bf2f(Hr[C_GT + h * 64 + dk]); kk_[i] = bf2f(Hr[C_KA + h * 64 + dk]); qq_[i] = bf2f(Hr[C_QA + h * 64 + dk]);
    }
#pragma unroll
    for (int i = 0; i < 16; ++i) {
        const int dk = dkg * 16 + i;
        const size_t si = ((size_t)(bs * 4 + h) * 64 + dk) * 128 + dv;
        const float sn = __expf(ga_[i]) * so[i] + kk_[i] * vv;
        F.out[O_SS + si] = sn;
        o += qq_[i] * sn;
    }
    red[dkg * 128 + dv] = o;
    __syncthreads();
    if (tid < 128) {
        const float ot = red[tid] + red[128 + tid] + red[256 + tid] + red[384 + tid];
        const float ss = wave_sum(ot * ot);
        if (F.lane == 0) red2[F.wave] = ss;
        red[tid] = ot;
    }
    __syncthreads();
    if (tid < 128) {
        const float ss = red2[0] + red2[1];
        const float rinv = 1.0f / sqrtf(ss * (1.f / 128.f) + RMS_EPS);
        F.MIX[(size_t)(MTOK + bs) * 1024 + h * 128 + tid] = f2bfs(red[tid] * rinv * F.gnorm[tid] * bf2f(Hr[C_GA + h * 128 + tid]));
    }
    __syncthreads();
}
__device__ __forceinline__ void samp_attn_item(Frame& F, int item) {
    const int bs = item >> 3, h = item & 7, w = F.wave, lane = F.lane;
    LAS float* lg = (LAS float*)F.lds;
    LAS float* part = lg + 392;
    const bf16* Hr = F.H + (size_t)(MTOK + bs) * NH;
    const int e = w * 49 + lane;
    const bool valid = (lane < 49) && (e < 387);
    if (valid) {
        const int p = e / 129, jj = e - p * 129, dist = jj << (2 * p);
        float dot = 0.f;
        if (dist == 0) {
#pragma unroll
            for (int c = 0; c < 8; ++c) { const v4u qw = *(const GAS v4u*)(Hr + C_QB + h * 64 + 8 * c), kw = *(const GAS v4u*)(Hr + C_KB + h * 64 + 8 * c);
                dot += bflo(qw.x) * bflo(kw.x) + bfhi(qw.x) * bfhi(kw.x) + bflo(qw.y) * bflo(kw.y) + bfhi(qw.y) * bfhi(kw.y) + bflo(qw.z) * bflo(kw.z) + bfhi(qw.z) * bfhi(kw.z) + bflo(qw.w) * bflo(kw.w) + bfhi(qw.w) * bfhi(kw.w); }
        } else {
            const float* kr = F.cache_k + (((size_t)bs * WPAST + (WPAST - dist)) * 8 + h) * 64;
#pragma unroll
            for (int c = 0; c < 8; ++c) { const v4u qw = *(const GAS v4u*)(Hr + C_QB + h * 64 + 8 * c); const f32x4 k0 = *(const GAS f32x4*)(kr + 8 * c), k1 = *(const GAS f32x4*)(kr + 8 * c + 4);
                dot += bflo(qw.x) * k0.x + bfhi(qw.x) * k0.y + bflo(qw.y) * k0.z + bfhi(qw.y) * k0.w + bflo(qw.z) * k1.x + bfhi(qw.z) * k1.y + bflo(qw.w) * k1.z + bfhi(qw.w) * k1.w; }
        }
        lg[e] = (dot + F.rel_bias[t5_bucket(dist) * 8 + h]) * LOG2E;
    }
    __syncthreads();
    float mx = -3e38f;
#pragma unroll
    for (int i = 0; i < 7; ++i) { const int ee = lane + 64 * i; if (ee < 387) mx = fmaxf(mx, lg[ee]); }
#pragma unroll
    for (int o = 1; o < 64; o <<= 1) mx = fmaxf(mx, __shfl_xor(mx, o));
    float sum = 0.f;
#pragma unroll
    for (int i = 0; i < 7; ++i) { const int ee = lane + 64 * i; if (ee < 387) sum += __builtin_amdgcn_exp2f(lg[ee] - mx); }
    sum = wave_sum(sum);
    float acc = 0.f;
    const float vnew = bf2f(Hr[C_VB + h * 64 + lane]);
#pragma unroll
    for (int i = 0; i < 49; ++i) {
        const int ee = w * 49 + i;
        if (ee < 387) {
            const int p = ee / 129, jj = ee - p * 129, dist = jj << (2 * p);
            const float pv = __builtin_amdgcn_exp2f(lg[ee] - mx);
            const float vv = (dist == 0) ? vnew : F.cache_v[(((size_t)bs * WPAST + (WPAST - (dist == 0 ? 1 : dist))) * 8 + h) * 64 + lane];
            acc += pv * vv;
        }
    }
    part[w * 64 + lane] = acc;
    __syncthreads();
    if (w == 0) {
        float tot = 0.f;
#pragma unroll
        for (int i = 0; i < 8; ++i) tot += part[i * 64 + lane];
        F.MIX[(size_t)(MTOK + bs) * 1024 + 512 + h * 64 + lane] = f2bfs(tot / sum * bf2f(Hr[C_GB + h * 64 + lane]));
    }
    __syncthreads();
}
__device__ __forceinline__ void samp_out_item(Frame& F, int item) {
    const int bs = item >> 3, cs = item & 7, lane = F.lane, w = F.wave;
    const bf16* mr = F.MIX + (size_t)(MTOK + bs) * 1024 + lane * 16;
    const v4u m0 = *(const GAS v4u*)(mr), m1 = *(const GAS v4u*)(mr + 8);
    float dots[16];
#pragma unroll
    for (int i = 0; i < 16; ++i) {
        const int dc = cs * 128 + w * 16 + i;
        const bf16* wr = F.WoT + (size_t)dc * 1024 + lane * 16;
        const v4u a0 = *(const GAS v4u*)(wr), a1 = *(const GAS v4u*)(wr + 8);
        dots[i] = bflo(m0.x) * bflo(a0.x) + bfhi(m0.x) * bfhi(a0.x) + bflo(m0.y) * bflo(a0.y) + bfhi(m0.y) * bfhi(a0.y) + bflo(m0.z) * bflo(a0.z) + bfhi(m0.z) * bfhi(a0.z) + bflo(m0.w) * bflo(a0.w) + bfhi(m0.w) * bfhi(a0.w)
                + bflo(m1.x) * bflo(a1.x) + bfhi(m1.x) * bfhi(a1.x) + bflo(m1.y) * bflo(a1.y) + bfhi(m1.y) * bfhi(a1.y) + bflo(m1.z) * bflo(a1.z) + bfhi(m1.z) * bfhi(a1.z) + bflo(m1.w) * bflo(a1.w) + bfhi(m1.w) * bfhi(a1.w);
    }
#pragma unroll
    for (int i = 0; i < 16; ++i) {
        const float t = wave_sum(dots[i]);
        const int dc = cs * 128 + w * 16 + i;
        if (lane == 0) F.YPRE[(size_t)(MTOK + bs) * 1024 + dc] = t + ALPHA * F.x_sample[bs * 1024 + dc];
    }
}
__device__ __forceinline__ void ln_rows(Frame& F) {
    const int gw = F.blk * NWAVES + F.wave, NGW = F.G * NWAVES;
    for (int m = gw; m < MTOK + NSAMP; m += NGW) {
        const GAS f32x4* xr = (const GAS f32x4*)(F.YPRE + (size_t)m * 1024) + F.lane;
        f32x4 v[4]; float s = 0.f;
#pragma unroll
        for (int j = 0; j < 4; ++j) { v[j] = xr[64 * j]; s += (v[j].x + v[j].y) + (v[j].z + v[j].w); }
        const float mean = wave_sum(s) * (1.f / 1024.f); float s2 = 0.f;
#pragma unroll
        for (int j = 0; j < 4; ++j) { v[j] = v[j] - mean; s2 += (v[j].x * v[j].x + v[j].y * v[j].y) + (v[j].z * v[j].z + v[j].w * v[j].w); }
        const float rstd = 1.0f / sqrtf(wave_sum(s2) * (1.f / 1024.f) + LN_EPS);
        GAS f32x4* o = (GAS f32x4*)(F.out + O_YP + (size_t)m * 1024) + F.lane;
#pragma unroll
        for (int j = 0; j < 4; ++j) { const f32x4 g = *((const GAS f32x4*)F.ln_g + F.lane + 64 * j), bb = *((const GAS f32x4*)F.ln_b + F.lane + 64 * j); o[64 * j] = v[j] * rstd * g + bb; }
    }
}

#ifndef PROBE_DUP
#define PROBE_DUP 0
#endif
struct Args { const float* in[13]; float* out; unsigned char* ws; int ph_lo, ph_hi; };
__global__ void __launch_bounds__(NWAVES * 64, 2) hymba_fwd(Args args) {
    extern __shared__ __attribute__((aligned(16))) unsigned char lds[];
    Frame F;
    F.lds = (LAS unsigned char*)lds;
    F.MISC = (volatile LAS unsigned*)(F.lds + MISC_OFF);
    F.tid = threadIdx.x; F.lane = F.tid & 63; F.wave = __builtin_amdgcn_readfirstlane(F.tid >> 6);
    F.G = gridDim.x; F.blk = blockIdx.x;
    unsigned char* ws = args.ws;
    F.ctl = (gu32*)(ws + WS_CTL);
    F.x_prompt = args.in[0]; F.x_sample = args.in[1]; F.state_gla = args.in[2]; F.cache_k = args.in[3]; F.cache_v = args.in[4]; F.w_in = args.in[5]; F.w_alpha2 = args.in[6];
    F.b_alpha = args.in[7]; F.gnorm = args.in[8]; F.w_out = args.in[9]; F.ln_g = args.in[10]; F.ln_b = args.in[11]; F.rel_bias = args.in[12];
    F.out = args.out;
    F.WinT = (bf16*)(ws + WS_WIN); F.WoT = (bf16*)(ws + WS_WO); F.XB = (bf16*)(ws + WS_XB); F.H = (bf16*)(ws + WS_H); F.MIX = (bf16*)(ws + WS_MIX);
    F.SBT = (bf16*)(ws + WS_SBT); F.OP = (bf16*)(ws + WS_OP); F.U = (float*)(ws + WS_U); F.DEC = (float*)(ws + WS_DEC); F.MS = (float*)(ws + WS_MS); F.YPRE = (float*)(ws + WS_YPRE);
    for (int u = F.tid; u < (LDS_BYTES - LDSCTL_OFF) / 4; u += NWAVES * 64) ((LAS unsigned*)(F.lds + LDSCTL_OFF))[u] = 0u;
    __syncthreads();
    const int lo = args.ph_lo, hi = args.ph_hi;
    const bool one = (hi - lo) > 1;
    XcdBarrier bar; bar.bar = (unsigned*)(F.ctl + CW_BAR); bar.x = 0; bar.st = nullptr;
    if (one) bar = xcd_barrier_post((unsigned*)(F.ctl + CW_BAR), F.MISC + 8);
#define IN(k) (lo <= (k) && (k) < hi)
#define SEAM(k) do { if (IN(k) && IN((k) + 1)) xcd_barrier(bar); } while (0)

    if (IN(0)) { p0_prologue(F);
#if PROBE_DUP == 1
        p0_prologue(F);
#endif
    } SEAM(0);
    if (IN(1)) {
        pg8::Gemm g{F.XB, F.WinT, MP, NH, DM}; pg8::StaticOrder S; S.init(MP, NH, F.G, F.blk);
        pg8::EpiInProj E{F.H, F.b_alpha, F.out + O_KP, F.out + O_VP, F.out + O_KS, F.out + O_VS};
        pg8::gemm_phase<pg8::EpiInProj, pg8::StaticOrder, true, true>(F.lds + RING_OFF, g, S, E);
#if PROBE_DUP == 2
        __syncthreads();
        pg8::gemm_phase<pg8::EpiInProj, pg8::StaticOrder, true, true>(F.lds + RING_OFF, g, S, E);
#endif
    } SEAM(1);
    if (IN(2)) {
        for (int u = F.blk; u < 512; u += F.G) attn_unit<0>(F, u);
#if PROBE_DUP == 3
        for (int u = F.blk; u < 512; u += F.G) attn_unit<0>(F, u);
#endif
#if PROBE_DUP == 4
        for (int it = F.blk; it < 1024; it += F.G) gla_local_item(F, it);
#endif
#if PROBE_DUP == 7
        for (int it = F.blk; it < 256; it += F.G) samp_attn_item(F, it);
        for (int it = F.blk; it < 128; it += F.G) samp_gla_item(F, it);
#endif
        for (int it = F.blk; it < 1024; it += F.G) gla_local_item(F, it);
        for (int it = F.blk; it < 256; it += F.G) samp_attn_item(F, it);
        for (int it = F.blk; it < 128; it += F.G) samp_gla_item(F, it);
    } SEAM(2);
    if (IN(3)) {
        for (int u = F.blk; u < 512; u += F.G) attn_unit<1>(F, u);
        if (F.blk < 256 && F.G >= 256) gla_scan(F);
        for (int it = F.blk; it < 256; it += F.G) samp_out_item(F, it);
#if PROBE_DUP == 6
        if (F.blk < 256 && F.G >= 256) gla_scan(F);
        for (int it = F.blk; it < 256; it += F.G) samp_out_item(F, it);
#endif
    } SEAM(3);
    if (IN(4)) {
        for (int u = F.blk; u < 512; u += F.G) attn_unit<2>(F, u);
        for (int it = F.blk; it < 1024; it += F.G) gla_out_item(F, it);
#if PROBE_DUP == 5
        for (int it = F.blk; it < 1024; it += F.G) gla_out_item(F, it);
#endif
    } SEAM(4);
    if (IN(5)) {
        pg8::Gemm g{F.MIX, F.WoT, MTOK, DM, DM}; pg8::StaticOrder S; S.init(MTOK, DM, F.G, F.blk);
        pg8::EpiYpre E{F.YPRE, F.x_prompt};
        pg8::gemm_phase<pg8::EpiYpre, pg8::StaticOrder, true, true>(F.lds + RING_OFF, g, S, E);
#if PROBE_DUP == 8
        __syncthreads();
        pg8::gemm_phase<pg8::EpiYpre, pg8::StaticOrder, true, true>(F.lds + RING_OFF, g, S, E);
#endif
    } SEAM(5);
    if (IN(6)) { ln_rows(F);
#if PROBE_DUP == 9
        ln_rows(F);
#endif
    }
#undef IN
#undef SEAM
}

#ifndef MK_N_LAUNCHES
#define MK_N_LAUNCHES 1
#endif
extern "C" void kernel_launch(void* const* d_in, const int* in_sizes, int n_in, void* d_out, int out_size, void* d_ws, size_t ws_size, hipStream_t stream) {
    static int grid = 0;
    if (grid == 0) {
        if (n_in != 13 || out_size != (int)O_END || ws_size < WS_END) { fprintf(stderr, "kernel_launch: unexpected shapes: n_in %d out %d ws %zu; nothing launched\n", n_in, out_size, ws_size); grid = -1; return; }
        int dev = 0, cus = 0;
        if (hipGetDevice(&dev) != hipSuccess || hipDeviceGetAttribute(&cus, hipDeviceAttributeMultiprocessorCount, dev) != hipSuccess) { grid = -1; return; }
        if (hipFuncSetAttribute((const void*)hymba_fwd, hipFuncAttributeMaxDynamicSharedMemorySize, LDS_BYTES) != hipSuccess) { fprintf(stderr, "kernel_launch: hipFuncSetAttribute failed\n"); grid = -1; return; }
        (void)hipGetLastError();
        grid = cus;
        if (grid != 256) fprintf(stderr, "kernel_launch: %d CUs (built for 256)\n", grid);
    }
    if (grid < 0) return;
    (void)hipMemsetAsync((char*)d_ws + WS_CTL, 0, CTL_ZERO_BYTES, stream);
    Args a{};
    for (int i = 0; i < 13; ++i) a.in[i] = (const float*)d_in[i];
    a.out = (float*)d_out; a.ws = (unsigned char*)d_ws;
#if MK_N_LAUNCHES == 1
    a.ph_lo = 0; a.ph_hi = 7;
    hipLaunchKernelGGL(hymba_fwd, dim3(grid), dim3(NWAVES * 64), LDS_BYTES, stream, a);
#else
    for (int p = 0; p < 7; ++p) { a.ph_lo = p; a.ph_hi = p + 1; hipLaunchKernelGGL(hymba_fwd, dim3(grid), dim3(NWAVES * 64), LDS_BYTES, stream, a); }
#endif
}
```
